# Optimizing an MI355X kernel written in HIP

```python
import math
import jax, jax.numpy as jnp
from jax import lax
import numpy as np

D_MODEL = 1024
BATCH = 8
SEQ = 2048
DEPTH = 2
DEC_BATCH = 128
DEC_SEQ = 8
PAST_LEN = 16384
PAGE_SIZE = 128

D_MIX = D_MODEL
DN_HEADS = 4
DN_DK = 128
DN_DV = 128
DN_QK = DN_HEADS * DN_DK
DN_V = DN_HEADS * DN_DV
DN_CONV = 4
DN_CHUNK = 64
QKV_DIM = 2 * DN_QK + DN_V
SG_GROUPS = 4
SG_CH = (D_MIX - DN_V) // SG_GROUPS
SG_WIDTH = SG_GROUPS * SG_CH
SG_CHUNK = 128
P_IN = QKV_DIM + DN_V + 2 * DN_HEADS + 2 * SG_WIDTH
MEM_LEN = 256
MEM_HEADS = 4
MEM_HD = D_MODEL // MEM_HEADS
PEER_HEADS = 8
PEER_NKEYS = 128
PEER_NEXP = PEER_NKEYS * PEER_NKEYS
PEER_DKEY = 128
PEER_TOPK = 16
PEER_BLOCK = 128
EPS = 1e-6

kernel_name = 'hymba_deltanet_sgu_peer_step'

F32 = jnp.float32


def _rmsnorm(x, g):
    xf = x.astype(F32)
    y = xf * lax.rsqrt(jnp.mean(xf * xf, axis=-1, keepdims=True) + EPS)
    return (y * g.astype(F32)).astype(x.dtype)


def _layernorm(x, g, b):
    xf = x.astype(F32)
    mu = jnp.mean(xf, axis=-1, keepdims=True)
    var = jnp.mean(jnp.square(xf - mu), axis=-1, keepdims=True)
    y = (xf - mu) * lax.rsqrt(var + EPS)
    return (y * g.astype(F32) + b.astype(F32)).astype(x.dtype)


def _l2norm(x):
    xf = x.astype(F32)
    return xf * lax.rsqrt(jnp.sum(xf * xf, axis=-1, keepdims=True) + EPS)


def _short_conv(x, buf, w):
    T = x.shape[1]
    xx = jnp.concatenate([buf.astype(x.dtype), x], axis=1)
    y = sum(xx[:, j:j + T, :] * w[j] for j in range(DN_CONV))
    return jax.nn.silu(y), xx[:, T:, :]


def _gated_delta(q, k, v, beta, g, S0):
    B, T = q.shape[0], q.shape[1]
    C = min(DN_CHUNK, T)
    n = -(-T // C)
    pad = n * C - T

    def prep(a):
        a = jnp.moveaxis(a.astype(F32), 1, 2)
        a = jnp.pad(a, [(0, 0), (0, 0), (0, pad)] + [(0, 0)] * (a.ndim - 3))
        return a.reshape(a.shape[:2] + (n, C) + a.shape[3:])

    q, k, v, beta, g = prep(q), prep(k), prep(v), prep(beta), prep(g)
    gc = jnp.cumsum(g, axis=-1)
    idx = jnp.arange(C)
    strict = idx[:, None] > idx[None, :]
    causal = idx[:, None] >= idx[None, :]
    diff = gc[..., :, None] - gc[..., None, :]
    kb = k * beta[..., None]
    A = jnp.einsum('bhncd,bhnsd->bhncs', kb, k) * jnp.exp(jnp.where(strict, diff, -jnp.inf))
    u = lax.linalg.triangular_solve(A, v * beta[..., None], left_side=True, lower=True, unit_diagonal=True)
    w = lax.linalg.triangular_solve(A, kb * jnp.exp(gc)[..., None], left_side=True, lower=True, unit_diagonal=True)
    qk = jnp.einsum('bhncd,bhnsd->bhncs', q, k) * jnp.exp(jnp.where(causal, diff, -jnp.inf))

    def step(S, xs):
        qn, kn, un, wn, gn, qkn = xs
        v_new = un - jnp.einsum('bhcd,bhde->bhce', wn, S)
        o = jnp.einsum('bhcd,bhde->bhce', qn * jnp.exp(gn)[..., None], S) + jnp.einsum('bhcs,bhse->bhce', qkn, v_new)
        glast = gn[..., -1]
        S = S * jnp.exp(glast)[..., None, None] + jnp.einsum(
            'bhcd,bhce->bhde', kn * jnp.exp(glast[..., None] - gn)[..., None], v_new)
        return S, o

    xs = tuple(jnp.moveaxis(a, 2, 0) for a in (q, k, u, w, gc, qk))
    S, o = lax.scan(step, S0.astype(F32), xs)
    o = jnp.moveaxis(o, 0, 2).reshape(B, DN_HEADS, n * C, DN_DV)[:, :, :T]
    return jnp.moveaxis(o, 1, 2), S


def _chunk_spatial_mix(v, w, b):
    B, T = v.shape[0], v.shape[1]
    nc = -(-T // SG_CHUNK)
    pad = nc * SG_CHUNK - T
    vp = jnp.pad(v, ((0, 0), (0, pad), (0, 0), (0, 0))).reshape(B, nc, SG_CHUNK, SG_GROUPS, SG_CH)
    tril = jnp.tril(jnp.ones((SG_CHUNK, SG_CHUNK), dtype=bool))
    wm = jnp.where(tril[None], w, jnp.zeros((), w.dtype))
    out = jnp.einsum('gts,bnsgc->bntgc', wm, vp) + b.T[None, None, :, :, None]
    return out.reshape(B, nc * SG_CHUNK, SG_GROUPS, SG_CH)[:, :T]


def _hybrid_mixer(n, S0, c0, w_in, conv_w, a_log, dt_bias, o_norm_g, sg_ln_g, sg_ln_b, sg_w, sg_b, w_out):
    B, T, _ = n.shape
    proj = n @ w_in
    o1 = QKV_DIM
    o2 = o1 + DN_V
    o3 = o2 + DN_HEADS
    o4 = o3 + DN_HEADS
    o5 = o4 + SG_WIDTH
    qkv, z, b_a, a_a, gu, gv = jnp.split(proj, [o1, o2, o3, o4, o5], axis=-1)
    qkv, conv_new = _short_conv(qkv, c0, conv_w)
    q, k, v = jnp.split(qkv, [DN_QK, 2 * DN_QK], axis=-1)
    q = _l2norm(q.reshape(B, T, DN_HEADS, DN_DK)) * (DN_DK ** -0.5)
    k = _l2norm(k.reshape(B, T, DN_HEADS, DN_DK))
    v = v.reshape(B, T, DN_HEADS, DN_DV)
    beta = jax.nn.sigmoid(b_a.astype(F32))
    g = -jnp.exp(a_log.astype(F32)) * jax.nn.softplus(a_a.astype(F32) + dt_bias.astype(F32))
    o, S = _gated_delta(q, k, v, beta, g, S0)
    o = _rmsnorm(o, o_norm_g) * jax.nn.silu(z.reshape(B, T, DN_HEADS, DN_DV).astype(F32))
    o_a = o.reshape(B, T, DN_V).astype(n.dtype)
    u = jax.nn.gelu(gu).reshape(B, T, SG_GROUPS, SG_CH)
    vv = _layernorm(jax.nn.gelu(gv).reshape(B, T, SG_GROUPS, SG_CH), sg_ln_g, sg_ln_b)
    o_b = (u * _chunk_spatial_mix(vv, sg_w, sg_b)).reshape(B, T, SG_WIDTH)
    y = jnp.concatenate([o_a, o_b.astype(n.dtype)], axis=-1) @ w_out
    return y, S, conv_new, vv.reshape(B, T, SG_WIDTH)


def _mem_kv(mem, g, wk, wv):
    m = _rmsnorm(mem, g)
    B, M = mem.shape[0], mem.shape[1]
    return (m @ wk).reshape(B, M, MEM_HEADS, MEM_HD), (m @ wv).reshape(B, M, MEM_HEADS, MEM_HD)


def _mem_attend(n, mk, mv, wq, wo):
    B, T, _ = n.shape
    q = (n @ wq).reshape(B, T, MEM_HEADS, MEM_HD)
    s = jnp.einsum('bthd,bmhd->bhtm', q, mk.astype(q.dtype)).astype(F32) * (MEM_HD ** -0.5)
    p = jax.nn.softmax(s, axis=-1).astype(n.dtype)
    o = jnp.einsum('bhtm,bmhd->bthd', p, mv.astype(n.dtype)).reshape(B, T, D_MODEL)
    return o @ wo


def _peer(n, wq, keys, u_tab, v_tab):
    B, T, D = n.shape
    N = B * T
    x = n.reshape(N, D)
    q = (x @ wq).reshape(N, PEER_HEADS, 2, PEER_DKEY // 2)
    s = jnp.einsum('thpd,hpkd->thpk', q, keys).astype(F32)
    sv, si = lax.top_k(s, PEER_TOPK)
    cand = sv[:, :, 0, :, None] + sv[:, :, 1, None, :]
    cv, ci = lax.top_k(cand.reshape(N, PEER_HEADS, PEER_TOPK * PEER_TOPK), PEER_TOPK)
    i1 = jnp.take_along_axis(si[:, :, 0], ci // PEER_TOPK, axis=-1)
    i2 = jnp.take_along_axis(si[:, :, 1], ci % PEER_TOPK, axis=-1)
    eidx = (i1 * PEER_NKEYS + i2).reshape(N, PEER_HEADS * PEER_TOPK)
    gate = jax.nn.softmax(cv, axis=-1).reshape(N, PEER_HEADS * PEER_TOPK)
    nb = -(-N // PEER_BLOCK)
    pad = nb * PEER_BLOCK - N
    xp = jnp.pad(x, ((0, pad), (0, 0))).reshape(nb, PEER_BLOCK, D)
    ip = jnp.pad(eidx, ((0, pad), (0, 0))).reshape(nb, PEER_BLOCK, -1)
    gp = jnp.pad(gate, ((0, pad), (0, 0))).reshape(nb, PEER_BLOCK, -1)

    def blk(args):
        xb, ib, gb = args
        h = jax.nn.gelu(jnp.einsum('tkd,td->tk', u_tab[ib], xb).astype(F32))
        return jnp.einsum('tk,tkd->td', (gb * h).astype(xb.dtype), v_tab[ib])

    out = lax.map(blk, (xp, ip, gp))
    return out.reshape(nb * PEER_BLOCK, D)[:N].reshape(B, T, D)


def _layer(h, mk, mv, S0, c0, w_in, conv_w, a_log, dt_bias, o_norm_g, sg_ln_g, sg_ln_b, sg_w, sg_b, w_out,
           norm_mix_g, norm_mem_g, w_mq, w_mo, norm_ffn_g, peer_wq, peer_keys, peer_u, peer_v):
    y, S, c, vrows = _hybrid_mixer(_rmsnorm(h, norm_mix_g), S0, c0, w_in, conv_w, a_log, dt_bias, o_norm_g,
                                   sg_ln_g, sg_ln_b, sg_w, sg_b, w_out)
    h = h + y
    h = h + _mem_attend(_rmsnorm(h, norm_mem_g), mk, mv, w_mq, w_mo)
    h = h + _peer(_rmsnorm(h, norm_ffn_g), peer_wq, peer_keys, peer_u, peer_v)
    return h, S, c, vrows


def setup_inputs(seed: int = 0) -> dict:
    key = jax.random.key(seed)
    ks = jax.random.split(key, 30)
    nrm = lambda k, shp, s: jax.random.normal(k, shp, F32) * s
    gain = lambda k, shp: 1.0 + 0.02 * jax.random.normal(k, shp, F32)
    dt = jnp.exp(jax.random.uniform(ks[10], (DEPTH, DN_HEADS), F32, math.log(1e-3), math.log(1e-1)))
    return {
        'x_prompt': nrm(ks[0], (BATCH, SEQ, D_MODEL), 1.0),
        'x_sample': nrm(ks[1], (DEC_BATCH, DEC_SEQ, D_MODEL), 1.0),
        'state_delta': nrm(ks[2], (DEPTH, DEC_BATCH, DN_HEADS, DN_DK, DN_DV), 0.1),
        'state_conv': nrm(ks[3], (DEPTH, DEC_BATCH, DN_CONV - 1, QKV_DIM), 1.0),
        'cache_mem_k': nrm(ks[4], (DEPTH, DEC_BATCH, MEM_LEN, MEM_HEADS, MEM_HD), 1.0),
        'cache_mem_v': nrm(ks[5], (DEPTH, DEC_BATCH, MEM_LEN, MEM_HEADS, MEM_HD), 1.0),
        'mem_prompt': nrm(ks[6], (BATCH, MEM_LEN, D_MODEL), 1.0),
        'w_in': nrm(ks[7], (DEPTH, D_MODEL, P_IN), D_MODEL ** -0.5),
        'conv_w': nrm(ks[8], (DEPTH, DN_CONV, QKV_DIM), DN_CONV ** -0.5),
        'a_log': jnp.log(jax.random.uniform(ks[9], (DEPTH, DN_HEADS), F32, 1.0, 16.0)),
        'dt_bias': dt + jnp.log(-jnp.expm1(-dt)),
        'o_norm_g': gain(ks[11], (DEPTH, DN_DV)),
        'sg_ln_g': gain(ks[12], (DEPTH, SG_GROUPS, SG_CH)),
        'sg_ln_b': nrm(ks[13], (DEPTH, SG_GROUPS, SG_CH), 0.02),
        'sg_w': nrm(ks[14], (DEPTH, SG_GROUPS, SG_CHUNK, SG_CHUNK), 0.5 * SG_CHUNK ** -0.5),
        'sg_b': gain(ks[15], (DEPTH, SG_GROUPS, SG_CHUNK)),
        'w_out': nrm(ks[16], (DEPTH, D_MIX, D_MODEL), D_MIX ** -0.5),
        'norm_mix_g': gain(ks[17], (DEPTH, D_MODEL)),
        'norm_mem_g': gain(ks[18], (DEPTH, D_MODEL)),
        'mem_norm_g': gain(ks[19], (DEPTH, D_MODEL)),
        'w_mq': nrm(ks[20], (DEPTH, D_MODEL, D_MODEL), D_MODEL ** -0.5),
        'w_mk': nrm(ks[21], (DEPTH, D_MODEL, D_MODEL), D_MODEL ** -0.5),
        'w_mv': nrm(ks[22], (DEPTH, D_MODEL, D_MODEL), D_MODEL ** -0.5),
        'w_mo': nrm(ks[23], (DEPTH, D_MODEL, D_MODEL), D_MODEL ** -0.5),
        'norm_ffn_g': gain(ks[24], (DEPTH, D_MODEL)),
        'peer_wq': nrm(ks[25], (DEPTH, D_MODEL, PEER_HEADS * PEER_DKEY), D_MODEL ** -0.5),
        'peer_keys': nrm(ks[26], (DEPTH, PEER_HEADS, 2, PEER_NKEYS, PEER_DKEY // 2), (PEER_DKEY // 2) ** -0.5),
        'peer_u': nrm(ks[27], (DEPTH, PEER_NEXP, D_MODEL), D_MODEL ** -0.5),
        'peer_v': nrm(ks[28], (DEPTH, PEER_NEXP, D_MODEL), (PEER_HEADS * PEER_TOPK) ** -0.5),
        'final_norm_g': gain(ks[29], (D_MODEL,)),
    }


def reference(x_prompt, x_sample, state_delta, state_conv, cache_mem_k, cache_mem_v, mem_prompt,
              w_in, conv_w, a_log, dt_bias, o_norm_g, sg_ln_g, sg_ln_b, sg_w, sg_b, w_out,
              norm_mix_g, norm_mem_g, mem_norm_g, w_mq, w_mk, w_mv, w_mo, norm_ffn_g,
              peer_wq, peer_keys, peer_u, peer_v, final_norm_g):
    hp, hs = x_prompt, x_sample
    Bp = x_prompt.shape[0]
    sd_p, sc_p, mk_p, mv_p, sd_s, sc_s, vr_s = [], [], [], [], [], [], []
    for l in range(DEPTH):
        lw = (w_in[l], conv_w[l], a_log[l], dt_bias[l], o_norm_g[l], sg_ln_g[l], sg_ln_b[l], sg_w[l], sg_b[l],
              w_out[l], norm_mix_g[l], norm_mem_g[l], w_mq[l], w_mo[l], norm_ffn_g[l],
              peer_wq[l], peer_keys[l], peer_u[l], peer_v[l])
        mk, mv = _mem_kv(mem_prompt, mem_norm_g[l], w_mk[l], w_mv[l])
        S0 = jnp.zeros((Bp, DN_HEADS, DN_DK, DN_DV), F32)
        c0 = jnp.zeros((Bp, DN_CONV - 1, QKV_DIM), hp.dtype)
        hp, Sp, cp, _ = _layer(hp, mk, mv, S0, c0, *lw)
        sd_p.append(Sp)
        sc_p.append(cp)
        mk_p.append(mk)
        mv_p.append(mv)
        hs, Ss, cs, vr = _layer(hs, cache_mem_k[l], cache_mem_v[l], state_delta[l], state_conv[l], *lw)
        sd_s.append(Ss)
        sc_s.append(cs)
        vr_s.append(vr)
    y_prompt = _rmsnorm(hp, final_norm_g)
    y_sample = _rmsnorm(hs, final_norm_g)
    state_delta_prompt = jnp.stack(sd_p)
    state_conv_prompt = jnp.stack(sc_p)
    cache_mem_k_prompt = jnp.stack(mk_p)
    cache_mem_v_prompt = jnp.stack(mv_p)
    state_delta_sample = jnp.stack(sd_s)
    state_conv_sample = jnp.stack(sc_s)
    sgu_v_rows_sample = jnp.stack(vr_s)
    return (y_prompt, y_sample, state_delta_prompt, state_conv_prompt, cache_mem_k_prompt, cache_mem_v_prompt,
            state_delta_sample, state_conv_sample, sgu_v_rows_sample)
```

```cpp
#include <hip/hip_runtime.h>
#include <hip/hip_cooperative_groups.h>
#include <stdint.h>
#include <cstdio>
namespace cg = cooperative_groups;

typedef unsigned short u16;
typedef __attribute__((ext_vector_type(8))) short bf16x8;
typedef __attribute__((ext_vector_type(4))) float f32x4;
typedef __attribute__((ext_vector_type(2))) __bf16 bf2_t;

#define NTOK 17408
#define NPR 16384
#define PIN 3080
#define WTROWS 9344

constexpr size_t O_YP = 0;
constexpr size_t O_YS = 16777216;
constexpr size_t O_SDP = 17825792;
constexpr size_t O_SCP = 18874368;
constexpr size_t O_MKP = 18948096;
constexpr size_t O_MVP = 23142400;
constexpr size_t O_SDS = 27336704;
constexpr size_t O_SCS = 44113920;
constexpr size_t O_VRS = 45293568;

constexpr size_t W_WT = 0;
constexpr size_t W_UB = W_WT + 2ull * WTROWS * 1024 * 2;
constexpr size_t W_VB = W_UB + 2ull * 16384 * 1024 * 2;
constexpr size_t W_H = W_VB + 2ull * 16384 * 1024 * 2;
constexpr size_t W_NB = W_H + (size_t)NTOK * 1024 * 4;
constexpr size_t W_PROJ = W_NB + (size_t)NTOK * 1024 * 2;
constexpr size_t W_QKV = W_PROJ + (size_t)NTOK * PIN * 2;
constexpr size_t W_BG = W_QKV + (size_t)NTOK * 1536 * 2;
constexpr size_t W_SU = W_BG + (size_t)NTOK * 12 * 4;
constexpr size_t W_VV = W_SU + (size_t)NTOK * 512 * 2;
constexpr size_t W_O = W_VV + (size_t)NTOK * 512 * 2;
constexpr size_t W_CAT = W_O + (size_t)NTOK * 512 * 4;
constexpr size_t W_QM = W_CAT + (size_t)NTOK * 1024 * 2;
constexpr size_t W_ATT = W_QM + (size_t)NTOK * 1024 * 2;
constexpr size_t W_PQ = W_ATT + (size_t)NTOK * 1024 * 2;
constexpr size_t W_EIDX = W_PQ + (size_t)NTOK * 1024 * 4;
constexpr size_t W_GATE = W_EIDX + (size_t)NTOK * 128 * 4;
constexpr size_t W_MEMN = W_GATE + (size_t)NTOK * 128 * 4;
constexpr size_t W_MKB = W_MEMN + 2ull * 2048 * 1024 * 2;
constexpr size_t W_MVT = W_MKB + 2ull * 2048 * 1024 * 2;
constexpr size_t W_END = W_MVT + 2ull * 2048 * 1024 * 2;
constexpr size_t W_BAR = W_END;
constexpr size_t W_KEYB = W_END + 16384;
constexpr size_t W_PART = W_KEYB + (1u << 20);

struct Params {
  const float *x_prompt, *x_sample, *state_delta, *state_conv, *cache_mem_k, *cache_mem_v, *mem_prompt;
  const float *w_in, *conv_w, *a_log, *dt_bias, *o_norm_g, *sg_ln_g, *sg_ln_b, *sg_w, *sg_b, *w_out;
  const float *norm_mix_g, *norm_mem_g, *mem_norm_g, *w_mq, *w_mk, *w_mv, *w_mo, *norm_ffn_g;
  const float *peer_wq, *peer_keys, *peer_u, *peer_v, *final_norm_g;
  float* out;
  unsigned char* ws;
};

#define SMEM_BYTES 77824
#ifndef PROBE_DUP
#define PROBE_DUP 0
#endif

__device__ __forceinline__ u16 f2bf(float f) {
  uint32_t u = __float_as_uint(f);
  u += 0x7fffu + ((u >> 16) & 1u);
  return (u16)(u >> 16);
}
__device__ __forceinline__ float bf2f(u16 h) { return __uint_as_float(((uint32_t)h) << 16); }
__device__ __forceinline__ uint32_t pack2(float a, float b) { return (uint32_t)f2bf(a) | ((uint32_t)f2bf(b) << 16); }
__device__ __forceinline__ float bflo(uint32_t u) { return __uint_as_float(u << 16); }
__device__ __forceinline__ float bfhi(uint32_t u) { return __uint_as_float(u & 0xffff0000u); }
__device__ __forceinline__ float wave_sum(float v) {
#pragma unroll
  for (int o = 32; o > 0; o >>= 1) v += __shfl_xor(v, o, 64);
  return v;
}
__device__ __forceinline__ int opq(int x) { asm volatile("" : "+v"(x)); return x; }
#define TIDX opq((int)threadIdx.x)
__device__ __forceinline__ float gelu_t(float x) {
  float e2 = -2.302208198144199f * (x + 0.044715f * x * x * x);
  e2 = fminf(e2, 80.f);
  return x * __builtin_amdgcn_rcpf(1.f + __builtin_amdgcn_exp2f(e2));
}
__device__ __forceinline__ float silu_f(float x) {
  const float e2 = fminf(-1.4426950408889634f * x, 80.f);
  return x * __builtin_amdgcn_rcpf(1.f + __builtin_amdgcn_exp2f(e2));
}
__device__ __forceinline__ float dot2bf(uint32_t a, uint32_t b, float c) {
  return __builtin_amdgcn_fdot2_f32_bf16(__builtin_bit_cast(bf2_t, a), __builtin_bit_cast(bf2_t, b), c, false);
}
__device__ __forceinline__ bf16x8 pack8(float4 a, float4 b) {
  union { uint32_t u[4]; bf16x8 v; } r;
  r.u[0] = pack2(a.x, a.y); r.u[1] = pack2(a.z, a.w); r.u[2] = pack2(b.x, b.y); r.u[3] = pack2(b.z, b.w);
  return r.v;
}
__device__ __forceinline__ const float* hsrc(const float* p0, const float* p1, int m) {
  return (m < NPR) ? p0 + (size_t)m * 1024 : p1 + (size_t)(m - NPR) * 1024;
}

__device__ __forceinline__ void rms_row_bf16(const float* src, const float* g, u16* dst, int lane) {
  float4 v[4];
  float ss = 0.f;
#pragma unroll
  for (int i = 0; i < 4; ++i) {
    v[i] = ((const float4*)src)[lane + 64 * i];
    ss += v[i].x * v[i].x + v[i].y * v[i].y + v[i].z * v[i].z + v[i].w * v[i].w;
  }
  ss = wave_sum(ss);
  float r = rsqrtf(ss * (1.f / 1024.f) + 1e-6f);
#pragma unroll
  for (int i = 0; i < 4; ++i) {
    float4 gg = ((const float4*)g)[lane + 64 * i];
    uint2 o;
    o.x = pack2(v[i].x * r * gg.x, v[i].y * r * gg.y);
    o.y = pack2(v[i].z * r * gg.z, v[i].w * r * gg.w);
    ((uint2*)dst)[lane + 64 * i] = o;
  }
}

#define XB_TMO      128
#define XB_XCNT(j)  (256  + 64 * (j))
#define XB_XSUB(j)  (1280 + 64 * (j))
#define XB_XGEN(j)  (2304 + 64 * (j))
#define XB_TOP      3328
#define XB_TOPGEN   3392
#define XCD_BAR_WORDS 3456
#define XB_SPIN_CAP (1u << 22)
#define LAS __attribute__((address_space(3)))
__device__ __forceinline__ unsigned xb_ld(unsigned* p) { return __hip_atomic_load(p, __ATOMIC_RELAXED, __HIP_MEMORY_SCOPE_AGENT); }
__device__ __forceinline__ unsigned xb_add(unsigned* p, unsigned v) { return __hip_atomic_fetch_add(p, v, __ATOMIC_RELAXED, __HIP_MEMORY_SCOPE_AGENT); }
__device__ __forceinline__ unsigned xb_xcc_id() { return (unsigned)__builtin_amdgcn_s_getreg((3 << 11) | 20) & 0xFu; }
#define XB_SPIN(cond, bar) do { unsigned _sp = 0; while (cond) { __builtin_amdgcn_s_sleep(1); \
    if ((++_sp & 255u) == 0u) { if (xb_ld(&(bar)[XB_TMO])) break; if (_sp > XB_SPIN_CAP) { atomicAdd(&(bar)[XB_TMO], 1u); break; } } } } while (0)
struct XcdBarrier { unsigned* bar; unsigned x; volatile LAS unsigned* st; };
__device__ __forceinline__ XcdBarrier xcd_barrier_post(unsigned* bar, volatile LAS unsigned* st) {
  XcdBarrier b; b.bar = bar; b.x = xb_xcc_id(); b.st = st;
  if (threadIdx.x == 0) (void)xb_add(&bar[XB_XCNT(b.x)], 1u);
  return b;
}
__device__ __forceinline__ void xcd_barrier_complete(unsigned* bar, unsigned x, unsigned& nloc, unsigned& nx) {
  const unsigned G = gridDim.x * gridDim.y * gridDim.z;
  unsigned sum, cnt, mine, sp = 0u;
  for (;;) {
    sum = 0u; cnt = 0u; mine = 0u;
#pragma unroll
    for (unsigned j = 0; j < 16; ++j) { const unsigned c = xb_ld(&bar[XB_XCNT(j)]); sum += c; cnt += (c > 0u) ? 1u : 0u; mine = (j == x) ? c : mine; }
    if (sum == G) break;
    __builtin_amdgcn_s_sleep(1);
    if ((++sp & 255u) == 0u) { if (xb_ld(&bar[XB_TMO])) break; if (sp > XB_SPIN_CAP) { atomicAdd(&bar[XB_TMO], 1u); break; } }
  }
  nloc = mine > 0u ? mine : 1u; nx = cnt > 0u ? cnt : 1u;
}
__device__ __forceinline__ void xcd_barrier(const XcdBarrier& b) {
  asm volatile("s_waitcnt vmcnt(0)" ::: "memory");
  __syncthreads();
  if (threadIdx.x == 0) {
    unsigned* bar = b.bar;
    __builtin_amdgcn_s_waitcnt(0);
    unsigned nloc = b.st[0], nx = b.st[1];
    if (nloc == 0u) { xcd_barrier_complete(bar, b.x, nloc, nx); b.st[0] = nloc; b.st[1] = nx; }
    const unsigned old = xb_add(&bar[XB_XSUB(b.x)], 1u);
    const unsigned gen = old / nloc;
    if (old + 1u == (gen + 1u) * nloc) {
      __builtin_amdgcn_fence(__ATOMIC_RELEASE, "agent");
      asm volatile("s_waitcnt vmcnt(0)" ::: "memory");
      const unsigned og = xb_add(&bar[XB_TOP], 1u);
      const unsigned tg = og / nx;
      if (og + 1u == (tg + 1u) * nx) xb_add(&bar[XB_TOPGEN], 1u);
      else XB_SPIN(xb_ld(&bar[XB_TOPGEN]) == tg, bar);
      __builtin_amdgcn_fence(__ATOMIC_ACQUIRE, "agent");
      xb_add(&bar[XB_XGEN(b.x)], 1u);
      asm volatile("s_waitcnt vmcnt(0)" ::: "memory");
    } else {
      XB_SPIN(xb_ld(&bar[XB_XGEN(b.x)]) == gen, bar);
      __builtin_amdgcn_fence(__ATOMIC_ACQUIRE, "agent");
      asm volatile("s_waitcnt vmcnt(0)" ::: "memory");
    }
  }
  __syncthreads();
}
template <int CTRL> __device__ __forceinline__ float dpp_f(float v) {
  return __int_as_float(__builtin_amdgcn_update_dpp(0, __float_as_int(v), CTRL, 0xf, 0xf, true));
}
__device__ __forceinline__ float row_sum16(float v) {
  v += dpp_f<0xB1>(v);
  v += dpp_f<0x4E>(v);
  v += dpp_f<0x141>(v);
  v += dpp_f<0x140>(v);
  return v;
}

template <class Epi>
__device__ __forceinline__ void gemm_tile(const u16* X, const u16* W, int m0, int n0, u16* lds, const Epi& epi) {
  const int tid = TIDX, lane = tid & 63, wave = tid >> 6;
  const int wm = wave & 1, wn = wave >> 1;
  u16* sX = lds;
  u16* sW = lds + 2 * 128 * 64;
  f32x4 acc[4][4];
#pragma unroll
  for (int i = 0; i < 4; ++i)
#pragma unroll
    for (int j = 0; j < 4; ++j) acc[i][j] = (f32x4){0.f, 0.f, 0.f, 0.f};
  const int lrow = tid >> 3, lcol = (tid & 7) * 8;
  const u16* gx = X + (size_t)(m0 + lrow) * 1024 + lcol;
  const u16* gw = W + (size_t)(n0 + lrow) * 1024 + lcol;
  const int lo = lrow * 64 + (((tid & 7) ^ ((lrow >> 1) & 7)) * 8);
  const int fsw = (lane >> 1) & 7, fq = lane >> 4, fr = lane & 15;
  uint4 ax0, ax1, ax2, ax3, aw0, aw1, aw2, aw3, bx0, bx1, bx2, bx3, bw0, bw1, bw2, bw3;
#define G_LOAD(P, kt_) do { const u16* x_ = gx + (kt_) * 64; const u16* w_ = gw + (kt_) * 64; \
    P##x0 = *(const uint4*)(x_); P##x1 = *(const uint4*)(x_ + 32 * 1024); P##x2 = *(const uint4*)(x_ + 64 * 1024); P##x3 = *(const uint4*)(x_ + 96 * 1024); \
    P##w0 = *(const uint4*)(w_); P##w1 = *(const uint4*)(w_ + 32 * 1024); P##w2 = *(const uint4*)(w_ + 64 * 1024); P##w3 = *(const uint4*)(w_ + 96 * 1024); } while (0)
#define G_STORE(P, b_) do { u16* x_ = sX + (b_) * 128 * 64 + lo; u16* w_ = sW + (b_) * 128 * 64 + lo; \
    *(uint4*)(x_) = P##x0; *(uint4*)(x_ + 32 * 64) = P##x1; *(uint4*)(x_ + 64 * 64) = P##x2; *(uint4*)(x_ + 96 * 64) = P##x3; \
    *(uint4*)(w_) = P##w0; *(uint4*)(w_ + 32 * 64) = P##w1; *(uint4*)(w_ + 64 * 64) = P##w2; *(uint4*)(w_ + 96 * 64) = P##w3; } while (0)
#define G_COMPUTE(b_) do { const u16* cx = sX + (b_) * 128 * 64; const u16* cw = sW + (b_) * 128 * 64; \
    _Pragma("unroll") for (int ks = 0; ks < 2; ++ks) { bf16x8 a[4], b[4]; \
      _Pragma("unroll") for (int i = 0; i < 4; ++i) a[i] = *(const bf16x8*)(cw + (wn * 64 + i * 16 + fr) * 64 + (((ks * 4 + fq) ^ fsw) * 8)); \
      _Pragma("unroll") for (int j = 0; j < 4; ++j) b[j] = *(const bf16x8*)(cx + (wm * 64 + j * 16 + fr) * 64 + (((ks * 4 + fq) ^ fsw) * 8)); \
      _Pragma("unroll") for (int i = 0; i < 4; ++i) _Pragma("unroll") for (int j = 0; j < 4; ++j) \
        acc[i][j] = __builtin_amdgcn_mfma_f32_16x16x32_bf16(a[i], b[j], acc[i][j], 0, 0, 0); } } while (0)
  G_LOAD(a, 0);
  G_STORE(a, 0);
  G_LOAD(a, 1);
  G_LOAD(b, 2);
  __syncthreads();
#pragma unroll 1
  for (int kt = 0; kt < 12; kt += 2) {
    G_STORE(a, 1);
    G_LOAD(a, kt + 3);
    G_COMPUTE(0);
    __syncthreads();
    G_STORE(b, 0);
    G_LOAD(b, kt + 4);
    G_COMPUTE(1);
    __syncthreads();
  }
  G_STORE(a, 1);
  G_LOAD(a, 15);
  G_COMPUTE(0);
  __syncthreads();
  G_STORE(b, 0);
  G_COMPUTE(1);
  __syncthreads();
  G_STORE(a, 1);
  G_COMPUTE(0);
  __syncthreads();
  G_COMPUTE(1);
  __syncthreads();
  __builtin_amdgcn_sched_barrier(0);
#pragma unroll
  for (int j = 0; j < 4; ++j) {
    const int m = opq(m0 + wm * 64 + j * 16 + (lane & 15));
    float rowv = epi.row_begin(m);
#pragma unroll
    for (int i = 0; i < 4; ++i) {
      const int n = n0 + wn * 64 + i * 16 + (lane >> 4) * 4;
      epi(m, n, acc[i][j], rowv);
    }
    epi.row_end(m, (n0 >> 7) * 2 + wn, lane, rowv);
  }
}

struct EpiBF16 {
  u16* C; int ldc; int nmax;
  __device__ __forceinline__ float row_begin(int) const { return 0.f; }
  __device__ __forceinline__ void row_end(int, int, int, float) const {}
  __device__ __forceinline__ void operator()(int m, int n, f32x4 v, float&) const {
    if (n < nmax) {
      uint2 o; o.x = pack2(v[0], v[1]); o.y = pack2(v[2], v[3]);
      *(uint2*)(C + (size_t)m * ldc + n) = o;
    }
  }
};
struct EpiBF16Rstd {
  u16* C; int ldc; int nmax; const float* part;
  __device__ __forceinline__ float row_begin(int m) const {
    const float4* q = (const float4*)(part + (size_t)m * 16);
    const float4 a = q[0], b = q[1], c = q[2], d = q[3];
    const float s = ((a.x + a.y) + (a.z + a.w)) + ((b.x + b.y) + (b.z + b.w)) + ((c.x + c.y) + (c.z + c.w)) + ((d.x + d.y) + (d.z + d.w));
    return rsqrtf(s * (1.f / 1024.f) + 1e-6f);
  }
  __device__ __forceinline__ void row_end(int, int, int, float) const {}
  __device__ __forceinline__ void operator()(int m, int n, f32x4 v, float& r) const {
    if (n < nmax) {
      uint2 o; o.x = pack2(v[0] * r, v[1] * r); o.y = pack2(v[2] * r, v[3] * r);
      *(uint2*)(C + (size_t)m * ldc + n) = o;
    }
  }
};
struct EpiRes {
  const float* p0; const float* p1; float* h; u16* hb; float* part; const float* gn;
  __device__ __forceinline__ float row_begin(int) const { return 0.f; }
  __device__ __forceinline__ void row_end(int m, int slot, int lane, float ss) const {
    ss += __shfl_xor(ss, 16, 64);
    ss += __shfl_xor(ss, 32, 64);
    if ((lane >> 4) == 0) part[(size_t)m * 16 + slot] = ss;
  }
  __device__ __forceinline__ void operator()(int m, int n, f32x4 v, float& ss) const {
    const float* s = hsrc(p0, p1, m);
    float4 a = *(const float4*)(s + n);
    const float h0 = a.x + v[0], h1 = a.y + v[1], h2 = a.z + v[2], h3 = a.w + v[3];
    *(float4*)(h + (size_t)m * 1024 + n) = make_float4(h0, h1, h2, h3);
    const float4 gq = *(const float4*)(gn + n);
    uint2 o; o.x = pack2(h0 * gq.x, h1 * gq.y); o.y = pack2(h2 * gq.z, h3 * gq.w);
    *(uint2*)(hb + (size_t)m * 1024 + n) = o;
    ss += h0 * h0 + h1 * h1 + h2 * h2 + h3 * h3;
  }
};
struct EpiMemKV {
  float* outK; float* outV; u16* mkb; u16* mvt;
  __device__ __forceinline__ float row_begin(int) const { return 0.f; }
  __device__ __forceinline__ void row_end(int, int, int, float) const {}
  __device__ __forceinline__ void operator()(int m, int n, f32x4 v, float&) const {
    if (n < 1024) {
      *(float4*)(outK + (size_t)m * 1024 + n) = make_float4(v[0], v[1], v[2], v[3]);
      uint2 o; o.x = pack2(v[0], v[1]); o.y = pack2(v[2], v[3]);
      *(uint2*)(mkb + (size_t)m * 1024 + n) = o;
    } else {
      int nn = n - 1024;
      *(float4*)(outV + (size_t)m * 1024 + nn) = make_float4(v[0], v[1], v[2], v[3]);
      int b = m >> 8, mm = m & 255;
#pragma unroll
      for (int r = 0; r < 4; ++r) mvt[((size_t)b * 1024 + nn + r) * 256 + mm] = f2bf(v[r]);
    }
  }
};

__device__ void convert_tables(const Params& p, int ob, int on, int lbeg, int lend) {
  const int tid = TIDX;
  const float4* u4 = (const float4*)p.peer_u; const float4* v4 = (const float4*)p.peer_v;
  uint4* ub = (uint4*)(p.ws + W_UB); uint4* vb = (uint4*)(p.ws + W_VB);
  const size_t per_layer = 16384ull * 1024 / 16;
  const size_t n16 = per_layer * lend;
  for (size_t i = per_layer * lbeg + (size_t)ob * 256 + tid; i < n16; i += (size_t)on * 256) {
    uint32_t o[4];
#pragma unroll
    for (int w = 0; w < 4; ++w) {
      float4 a = u4[4 * i + w];
      int r = __builtin_amdgcn_cvt_pk_fp8_f32(a.x * 128.f, a.y * 128.f, 0, false);
      r = __builtin_amdgcn_cvt_pk_fp8_f32(a.z * 128.f, a.w * 128.f, r, true);
      o[w] = (uint32_t)r;
    }
    ub[i] = make_uint4(o[0], o[1], o[2], o[3]);
#pragma unroll
    for (int w = 0; w < 4; ++w) {
      float4 a = v4[4 * i + w];
      int r = __builtin_amdgcn_cvt_pk_fp8_f32(a.x * 64.f, a.y * 64.f, 0, false);
      r = __builtin_amdgcn_cvt_pk_fp8_f32(a.z * 64.f, a.w * 64.f, r, true);
      o[w] = (uint32_t)r;
    }
    vb[i] = make_uint4(o[0], o[1], o[2], o[3]);
  }
}
__device__ void phase0a(const Params& p, unsigned char* smem) {
  const int tid = TIDX, bid = blockIdx.x, nb = gridDim.x;
  const int lane = tid & 63, wave = tid >> 6;
  float* tile = (float*)smem;
  u16* WT = (u16*)(p.ws + W_WT);
  for (int it = bid; it < 2 * 2336; it += nb) {
    int l = it / 2336, r = it % 2336;
    int kt = r & 15, nt = r >> 4;
    const float* src; int N, drow, ntl;
    if (nt < 50) { src = p.w_in + (size_t)l * 1024 * PIN; N = PIN; drow = 0; ntl = nt; }
    else {
      int q = (nt - 50) >> 4; ntl = (nt - 50) & 15; N = 1024; drow = 3200 + q * 1024;

      const float* base = q == 0 ? p.w_out : q == 1 ? p.w_mq : q == 2 ? p.w_mo : q == 3 ? p.peer_wq : q == 4 ? p.w_mk : p.w_mv;
      src = base + (size_t)l * 1024 * 1024;
    }
    int k0 = kt * 64, n0 = ntl * 64;
#pragma unroll
    for (int i = 0; i < 4; ++i) {
      int rr = (tid >> 4) + 16 * i, c4 = (tid & 15) * 4;
      float4 v = make_float4(0.f, 0.f, 0.f, 0.f);
      if (n0 + c4 < N) v = *(const float4*)(src + (size_t)(k0 + rr) * N + n0 + c4);
      tile[rr * 65 + c4 + 0] = v.x; tile[rr * 65 + c4 + 1] = v.y; tile[rr * 65 + c4 + 2] = v.z; tile[rr * 65 + c4 + 3] = v.w;
    }
    __syncthreads();
    {
      int n = tid >> 2, ks = (tid & 3) * 16;
      uint32_t o[8];
#pragma unroll
      for (int j = 0; j < 8; ++j) o[j] = pack2(tile[(ks + 2 * j) * 65 + n], tile[(ks + 2 * j + 1) * 65 + n]);
      u16* d = WT + ((size_t)l * WTROWS + drow + n0 + n) * 1024 + k0 + ks;
      *(uint4*)d = make_uint4(o[0], o[1], o[2], o[3]);
      *(uint4*)(d + 8) = make_uint4(o[4], o[5], o[6], o[7]);
    }
    __syncthreads();
  }
  if (gridDim.x <= 256) convert_tables(p, bid, nb, 0, 2);
  {
    u16* keyb = (u16*)(p.ws + W_KEYB);
    for (int i = bid * 256 + tid; i < 2 * 8 * 2 * 128 * 64 / 4; i += nb * 256) {
      float4 a = ((const float4*)p.peer_keys)[i];
      *(uint2*)(keyb + (size_t)i * 4) = make_uint2(pack2(a.x, a.y), pack2(a.z, a.w));
    }
  }
  const int gw = bid * 4 + wave, nw = nb * 4;
  {
    u16* memn = (u16*)(p.ws + W_MEMN);
    for (int r = gw; r < 4096; r += nw) {
      int l = r >> 11, row = r & 2047;
      rms_row_bf16(p.mem_prompt + (size_t)row * 1024, p.mem_norm_g + l * 1024, memn + ((size_t)l * 2048 + row) * 1024, lane);
    }
  }
  {
    u16* nbuf = (u16*)(p.ws + W_NB);
    for (int t = gw; t < NTOK; t += nw)
      rms_row_bf16(hsrc(p.x_prompt, p.x_sample, t), p.norm_mix_g, nbuf + (size_t)t * 1024, lane);
  }
}

__device__ void phase_norm(const Params& p, const float* g) {
  const int lane = TIDX & 63, gw = blockIdx.x * 4 + (TIDX >> 6), nw = gridDim.x * 4;
  const float* h = (const float*)(p.ws + W_H);
  u16* nbuf = (u16*)(p.ws + W_NB);
  for (int t = gw; t < NTOK; t += nw) rms_row_bf16(h + (size_t)t * 1024, g, nbuf + (size_t)t * 1024, lane);
}

__device__ void phase_g1(const Params& p, int l, unsigned char* smem) {
  const u16* WT = (const u16*)(p.ws + W_WT) + (size_t)l * WTROWS * 1024;
  const u16* nbuf = (const u16*)(p.ws + W_NB);
  const int ntile = 136 * 25 + (l == 0 ? 512 : 0);
  for (int it = blockIdx.x; it < ntile; it += gridDim.x) {
    if (it < 3400) {
      const int xcd = it & 7, j = it >> 3;
      int mt = (j / 25) * 8 + xcd, ct = j % 25;
      EpiBF16 e{(u16*)(p.ws + W_PROJ), PIN, PIN};
      gemm_tile(nbuf, WT, mt * 128, ct * 128, (u16*)smem, e);
    } else {
      int r = it - 3400; int ll = r >> 8; r &= 255;
      int mt = r >> 4, ct = r & 15;
      const u16* WT2 = (const u16*)(p.ws + W_WT) + ((size_t)ll * WTROWS + 7296) * 1024;
      EpiMemKV e{p.out + O_MKP + (size_t)ll * 2048 * 1024, p.out + O_MVP + (size_t)ll * 2048 * 1024,
                 (u16*)(p.ws + W_MKB) + (size_t)ll * 2048 * 1024, (u16*)(p.ws + W_MVT) + (size_t)ll * 2048 * 1024};
      gemm_tile((const u16*)(p.ws + W_MEMN) + (size_t)ll * 2048 * 1024, WT2, mt * 128, ct * 128, (u16*)smem, e);
    }
  }
}
template <class Epi>
__device__ void phase_gemm1024(const u16* X, const u16* W, unsigned char* smem, const Epi& e) {
  for (int it = blockIdx.x; it < 136 * 8; it += gridDim.x) {
    const int xcd = it & 7, j = it >> 3;
    int mt = (j >> 3) * 8 + xcd, ct = j & 7;
    gemm_tile(X, W, mt * 128, ct * 128, (u16*)smem, e);
  }
}

__device__ __forceinline__ void unpack8(const uint4 u, float (&f)[8]) {
  f[0] = bflo(u.x); f[1] = bfhi(u.x); f[2] = bflo(u.y); f[3] = bfhi(u.y);
  f[4] = bflo(u.z); f[5] = bfhi(u.z); f[6] = bflo(u.w); f[7] = bfhi(u.w);
}
__device__ __forceinline__ uint4 pack8u(const float (&f)[8]) {
  return make_uint4(pack2(f[0], f[1]), pack2(f[2], f[3]), pack2(f[4], f[5]), pack2(f[6], f[7]));
}
__device__ __forceinline__ void conv_finish(const Params& p, int l, int t, int ps, int lane, bool smp, int b, int tp, int T, const float (&xr)[4][8],
                                            const float* cw, u16* qkv, float* bg, float (&yq)[8]) {
  const int c = ps * 512 + lane * 8;
  float y[8];
#pragma unroll
  for (int i = 0; i < 8; ++i) y[i] = 0.f;
#pragma unroll
  for (int j = 0; j < 4; ++j) {
    float4 w0 = *(const float4*)(cw + j * 1536 + c), w1 = *(const float4*)(cw + j * 1536 + c + 4);
    y[0] += w0.x * xr[j][0]; y[1] += w0.y * xr[j][1]; y[2] += w0.z * xr[j][2]; y[3] += w0.w * xr[j][3];
    y[4] += w1.x * xr[j][4]; y[5] += w1.y * xr[j][5]; y[6] += w1.z * xr[j][6]; y[7] += w1.w * xr[j][7];
  }
#pragma unroll
  for (int i = 0; i < 8; ++i) y[i] = silu_f(y[i]);
  if (ps < 2) {
    float ss = 0.f;
#pragma unroll
    for (int i = 0; i < 8; ++i) ss += y[i] * y[i];
    ss = row_sum16(ss);
    float r = rsqrtf(ss + 1e-6f);
    if (ps == 0) r *= 0.08838834764831845f;
#pragma unroll
    for (int i = 0; i < 8; ++i) y[i] *= r;
  }
  const uint4 ypk = pack8u(y);
  *(uint4*)(qkv + (size_t)t * 1536 + c) = ypk;
  if (ps == 0) unpack8(ypk, yq);
  if (ps == 1) {
    float yk[8];
    unpack8(ypk, yk);
    float d = 0.f;
#pragma unroll
    for (int i = 0; i < 8; ++i) d += yq[i] * yk[i];
    d = row_sum16(d);
    if ((lane & 15) == 0) bg[(size_t)t * 12 + 8 + (lane >> 4)] = d;
  }
  if (tp >= T - 3) {
    float* o = (smp ? p.out + O_SCS + ((size_t)(l * 128 + b) * 3 + (tp - (T - 3))) * 1536
                    : p.out + O_SCP + ((size_t)(l * 8 + b) * 3 + (tp - (T - 3))) * 1536) + c;
    *(float4*)o = make_float4(xr[3][0], xr[3][1], xr[3][2], xr[3][3]);
    *(float4*)(o + 4) = make_float4(xr[3][4], xr[3][5], xr[3][6], xr[3][7]);
  }
}
__device__ void phase_prep(const Params& p, int l, unsigned char* smem) {
  const int lane = TIDX & 63, gw = blockIdx.x * 4 + (TIDX >> 6), nw = gridDim.x * 4;
  const u16* proj = (const u16*)(p.ws + W_PROJ);
  u16* qkv = (u16*)(p.ws + W_QKV);
  float* bg = (float*)(p.ws + W_BG);
  u16* su = (u16*)(p.ws + W_SU);
  u16* vvb = (u16*)(p.ws + W_VV);
  float* cwl = (float*)smem;
  float* lgl = cwl + 4 * 1536;
  float* lbl = lgl + 512;
  {
    const int tid = TIDX;
    const float4* s4 = (const float4*)(p.conv_w + (size_t)l * 4 * 1536);
    for (int i = tid; i < 1536; i += 256) ((float4*)cwl)[i] = s4[i];
    if (tid < 128) ((float4*)lgl)[tid] = ((const float4*)(p.sg_ln_g + (size_t)l * 512))[tid];
    else ((float4*)lbl)[tid - 128] = ((const float4*)(p.sg_ln_b + (size_t)l * 512))[tid - 128];
    __syncthreads();
  }
  const float* cw = cwl;
  for (int t = gw; t < NTOK; t += nw) {
    const bool smp = t >= NPR;
    int b, tp, T;
    if (!smp) { b = t >> 11; tp = t & 2047; T = 2048; } else { b = (t - NPR) >> 3; tp = (t - NPR) & 7; T = 8; }
    const u16* pr = proj + (size_t)t * PIN;
    const float* sc = p.state_conv + ((size_t)(l * 128 + (smp ? b : 0)) * 3) * 1536;
    float yq[8];
    const uint4 ugu = *(const uint4*)(pr + 2056 + lane * 8);
    const uint4 ugv = *(const uint4*)(pr + 2568 + lane * 8);
    if (tp >= 3) {
      uint4 rr[3][4];
#pragma unroll
      for (int ps = 0; ps < 3; ++ps)
#pragma unroll
        for (int j = 0; j < 4; ++j) rr[ps][j] = *(const uint4*)(pr - (size_t)(3 - j) * PIN + ps * 512 + lane * 8);
#pragma unroll
      for (int ps = 0; ps < 3; ++ps) {
        float xr[4][8];
#pragma unroll
        for (int j = 0; j < 4; ++j) unpack8(rr[ps][j], xr[j]);
        conv_finish(p, l, t, ps, lane, smp, b, tp, T, xr, cw, qkv, bg, yq);
      }
    } else {
#pragma unroll
      for (int ps = 0; ps < 3; ++ps) {
        const int c = ps * 512 + lane * 8;
        float xr[4][8];
#pragma unroll
        for (int j = 0; j < 4; ++j) {
          const int back = 3 - j;
          if (tp >= back) {
            unpack8(*(const uint4*)(pr - (size_t)back * PIN + c), xr[j]);
          } else if (smp) {
            const float* s_ = sc + (size_t)(3 + tp - back) * 1536 + c;
            float4 f0 = *(const float4*)s_, f1 = *(const float4*)(s_ + 4);
            xr[j][0] = f0.x; xr[j][1] = f0.y; xr[j][2] = f0.z; xr[j][3] = f0.w; xr[j][4] = f1.x; xr[j][5] = f1.y; xr[j][6] = f1.z; xr[j][7] = f1.w;
          } else {
#pragma unroll
            for (int i = 0; i < 8; ++i) xr[j][i] = 0.f;
          }
        }
        conv_finish(p, l, t, ps, lane, smp, b, tp, T, xr, cw, qkv, bg, yq);
      }
    }
    if (lane < 4) {
      float ba = bf2f(pr[2048 + lane]), aa = bf2f(pr[2052 + lane]);
      float beta = 1.f / (1.f + __expf(-ba));
      float xx = aa + p.dt_bias[l * 4 + lane];
      float sp = xx > 20.f ? xx : log1pf(__expf(xx));
      float g = -__expf(p.a_log[l * 4 + lane]) * sp;
      bg[(size_t)t * 12 + lane] = beta;
      bg[(size_t)t * 12 + 4 + lane] = __expf(g);
    }
    {
      const int c = lane * 8;
      float u[8], gv[8];
      unpack8(ugu, u);
      unpack8(ugv, gv);
#pragma unroll
      for (int i = 0; i < 8; ++i) { u[i] = gelu_t(u[i]); gv[i] = gelu_t(gv[i]); }
      *(uint4*)(su + (size_t)t * 512 + c) = pack8u(u);
      float s1 = 0.f;
#pragma unroll
      for (int i = 0; i < 8; ++i) s1 += gv[i];
      const float mu = row_sum16(s1) * (1.f / 128.f);
      float s2 = 0.f;
#pragma unroll
      for (int i = 0; i < 8; ++i) { gv[i] -= mu; s2 += gv[i] * gv[i]; }
      const float r = rsqrtf(row_sum16(s2) * (1.f / 128.f) + 1e-6f);
      const float* lg = lgl + c;
      const float* lb = lbl + c;
      float4 g0 = *(const float4*)lg, g1 = *(const float4*)(lg + 4), b0 = *(const float4*)lb, b1 = *(const float4*)(lb + 4);
      float o[8];
      o[0] = gv[0] * r * g0.x + b0.x; o[1] = gv[1] * r * g0.y + b0.y; o[2] = gv[2] * r * g0.z + b0.z; o[3] = gv[3] * r * g0.w + b0.w;
      o[4] = gv[4] * r * g1.x + b1.x; o[5] = gv[5] * r * g1.y + b1.y; o[6] = gv[6] * r * g1.z + b1.z; o[7] = gv[7] * r * g1.w + b1.w;
      *(uint4*)(vvb + (size_t)t * 512 + c) = pack8u(o);
      if (smp) {
        float* d = p.out + O_VRS + ((size_t)(l * 128 + b) * 8 + tp) * 512 + c;
        *(float4*)d = make_float4(o[0], o[1], o[2], o[3]);
        *(float4*)(d + 4) = make_float4(o[4], o[5], o[6], o[7]);
      }
    }
  }
}

typedef __attribute__((ext_vector_type(2))) float v2f;
__device__ __forceinline__ void delta_prompt_wave(const Params& p, int l, int wi, int lane, unsigned char* smem) {
  const int b = wi >> 7, h = (wi >> 5) & 3, sl = wi & 31;
  const int c = lane >> 4, rg = lane & 15, e0 = sl * 4, d0 = rg * 8;
  const u16* qkv = (const u16*)(p.ws + W_QKV);
  const float* bg = (const float*)(p.ws + W_BG);
  float* ob = (float*)(p.ws + W_O);
  constexpr int WB = 8192 + 128 + 128;
  v2f S0 = {0.f, 0.f}, S1 = {0.f, 0.f}, S2 = {0.f, 0.f}, S3 = {0.f, 0.f};
  const size_t tbase = (size_t)b * 2048;
  uint4 r0, r1, r2, r3; uint2 rv = make_uint2(0, 0); float rba = 0.f;
  const int p0 = lane & 31, tk0 = lane >> 5;
  const size_t koff = (size_t)tk0 * 1536 + (p0 < 16 ? 512 + h * 128 + p0 * 8 : h * 128 + (p0 - 16) * 8);
  const int loff = (tk0 * 256 + p0 * 8) * 4;
#define DQ_LOAD(ci_) do { const size_t tb_ = tbase + (size_t)(ci_) * 8; const u16* q0_ = qkv + tb_ * 1536 + koff; \
    r0 = *(const uint4*)(q0_); r1 = *(const uint4*)(q0_ + 2 * 1536); r2 = *(const uint4*)(q0_ + 4 * 1536); r3 = *(const uint4*)(q0_ + 6 * 1536); \
    if (lane < 8) rv = *(const uint2*)(qkv + (tb_ + lane) * 1536 + 1024 + h * 128 + e0); \
    else if (lane < 40) rba = (((lane - 8) & 3) < 3) ? bg[(tb_ + ((lane - 8) >> 2)) * 12 + ((lane - 8) & 3) * 4 + h] : 0.f; } while (0)
#define DQ_ST1(dst_, r_) do { *(float4*)(dst_) = make_float4(bflo(r_.x), bfhi(r_.x), bflo(r_.y), bfhi(r_.y)); \
    *(float4*)((dst_) + 16) = make_float4(bflo(r_.z), bfhi(r_.z), bflo(r_.w), bfhi(r_.w)); } while (0)
#define DQ_STORE(bi_) do { unsigned char* b_ = wbase + (bi_) * WB; \
    DQ_ST1(b_ + loff, r0); DQ_ST1(b_ + loff + 2048, r1); DQ_ST1(b_ + loff + 4096, r2); DQ_ST1(b_ + loff + 6144, r3); \
    if (lane < 8) *(float4*)(b_ + 8192 + lane * 16) = make_float4(bflo(rv.x), bfhi(rv.x), bflo(rv.y), bfhi(rv.y)); \
    else if (lane < 40) *(float*)(b_ + 8320 + (lane - 8) * 4) = rba; } while (0)
  unsigned char* wbase = smem + (wi & 3) * (2 * WB);
  DQ_LOAD(0);
  DQ_STORE(0);
  DQ_LOAD(1);
  for (int ci = 0; ci < 256; ++ci) {
    if (ci + 1 < 256) DQ_STORE((ci + 1) & 1);
    if (ci + 2 < 256) DQ_LOAD(ci + 2);
    const unsigned char* base = wbase + (ci & 1) * WB;
    float* o_ = ob + (tbase + (size_t)ci * 8) * 512 + h * 128 + e0 + c;
    float4 ka = *(const float4*)(base + d0 * 4), kb = *(const float4*)(base + d0 * 4 + 16);
    float4 qa = *(const float4*)(base + 512 + d0 * 4), qb = *(const float4*)(base + 512 + d0 * 4 + 16);
    float v = *(const float*)(base + 8192 + c * 4);
    float4 ba = *(const float4*)(base + 8320);
    float ov[8];
#pragma unroll
    for (int s = 0; s < 8; ++s) {
      const v2f k0 = {ka.x, ka.y}, k1 = {ka.z, ka.w}, k2 = {kb.x, kb.y}, k3 = {kb.z, kb.w};
      const v2f q0 = {qa.x, qa.y}, q1 = {qa.z, qa.w}, q2 = {qb.x, qb.y}, q3 = {qb.z, qb.w};
      const float beta = ba.x, a = ba.y, kq = ba.z;
      const float vcur = v;
      if (s < 7) {
        ka = *(const float4*)(base + (s + 1) * 1024 + d0 * 4); kb = *(const float4*)(base + (s + 1) * 1024 + d0 * 4 + 16);
        qa = *(const float4*)(base + (s + 1) * 1024 + 512 + d0 * 4); qb = *(const float4*)(base + (s + 1) * 1024 + 512 + d0 * 4 + 16);
        v = *(const float*)(base + 8192 + ((s + 1) * 4 + c) * 4);
        ba = *(const float4*)(base + 8320 + (s + 1) * 16);
      }
      const v2f pk2 = (S0 * k0 + S1 * k1) + (S2 * k2 + S3 * k3);
      const v2f pq2 = (S0 * q0 + S1 * q1) + (S2 * q2 + S3 * q3);
      float pk = pk2[0] + pk2[1], pq = pq2[0] + pq2[1];
      const v2f a2 = {a, a};
      const v2f aS0 = a2 * S0, aS1 = a2 * S1, aS2 = a2 * S2, aS3 = a2 * S3;
      pk = row_sum16(pk); pq = row_sum16(pq);
      const float vn = beta * (vcur - a * pk);
      const v2f vn2 = {vn, vn};
      S0 = aS0 + k0 * vn2; S1 = aS1 + k1 * vn2; S2 = aS2 + k2 * vn2; S3 = aS3 + k3 * vn2;
      ov[s] = a * pq + vn * kq;
    }
    if (rg == 0) {
#pragma unroll
      for (int s = 0; s < 8; ++s) o_[s * 512] = ov[s];
    }
  }
  float* so = p.out + O_SDP + ((size_t)((l * 8 + b) * 4 + h) * 128) * 128 + (size_t)d0 * 128 + e0 + c;
  so[0] = S0[0]; so[128] = S0[1]; so[256] = S1[0]; so[384] = S1[1]; so[512] = S2[0]; so[640] = S2[1]; so[768] = S3[0]; so[896] = S3[1];
}

__device__ void delta_sample_block(const Params& p, int l, int item, unsigned char* smem) {
  const int tid = TIDX, lane = tid & 63, wave = tid >> 6;
  float* skq = (float*)smem;
  float* skk = skq + 8 * 256;
  const u16* qkv = (const u16*)(p.ws + W_QKV);
  const float* bg = (const float*)(p.ws + W_BG);
  float* ob = (float*)(p.ws + W_O);
  const int b = item >> 2, h = item & 3;
  for (int i = tid; i < 8 * 256; i += 256) {
    int t = i >> 8, d = i & 255;
    size_t tok = NPR + (size_t)b * 8 + t;
    float v = (d < 128) ? bf2f(qkv[tok * 1536 + 512 + h * 128 + d]) : bf2f(qkv[tok * 1536 + h * 128 + (d - 128)]);
    skq[i] = v;
  }
  __syncthreads();
  if (tid < 8) {
    const float* r = skq + tid * 256;
    float s = 0.f;
    for (int d = 0; d < 128; ++d) s += r[d] * r[128 + d];
    skk[tid] = s;
  }
  __syncthreads();
  {
    const int e = wave * 32 + (lane & 31);
    const int rh = lane >> 5;
    const float* s0 = p.state_delta + ((size_t)((l * 128 + b) * 4 + h) * 128 + rh * 64) * 128 + e;
    float S[64];
#pragma unroll
    for (int d = 0; d < 64; ++d) S[d] = s0[(size_t)d * 128];
    for (int t = 0; t < 8; ++t) {
      const size_t tok = NPR + (size_t)b * 8 + t;
      const float* kr = skq + t * 256 + rh * 64;
      float pk = 0.f, pq = 0.f;
#pragma unroll
      for (int d4 = 0; d4 < 16; ++d4) {
        float4 kk = *(const float4*)(kr + d4 * 4);
        float4 qq = *(const float4*)(kr + 128 + d4 * 4);
        pk += S[d4 * 4 + 0] * kk.x + S[d4 * 4 + 1] * kk.y + S[d4 * 4 + 2] * kk.z + S[d4 * 4 + 3] * kk.w;
        pq += S[d4 * 4 + 0] * qq.x + S[d4 * 4 + 1] * qq.y + S[d4 * 4 + 2] * qq.z + S[d4 * 4 + 3] * qq.w;
      }
      pk += __shfl_xor(pk, 32, 64);
      pq += __shfl_xor(pq, 32, 64);
      const float a = bg[tok * 12 + 4 + h], beta = bg[tok * 12 + h];
      const float v = bf2f(qkv[tok * 1536 + 1024 + h * 128 + e]);
      const float vn = beta * (v - a * pk);
      const float o = a * pq + vn * skk[t];
#pragma unroll
      for (int d4 = 0; d4 < 16; ++d4) {
        float4 kk = *(const float4*)(kr + d4 * 4);
        S[d4 * 4 + 0] = a * S[d4 * 4 + 0] + kk.x * vn;
        S[d4 * 4 + 1] = a * S[d4 * 4 + 1] + kk.y * vn;
        S[d4 * 4 + 2] = a * S[d4 * 4 + 2] + kk.z * vn;
        S[d4 * 4 + 3] = a * S[d4 * 4 + 3] + kk.w * vn;
      }
      if (lane < 32) ob[tok * 512 + h * 128 + e] = o;
    }
    float* so = p.out + O_SDS + ((size_t)((l * 128 + b) * 4 + h) * 128 + rh * 64) * 128 + e;
#pragma unroll
    for (int d = 0; d < 64; ++d) so[(size_t)d * 128] = S[d];
  }
  __syncthreads();
}

__device__ void sgu_prompt_block(const Params& p, int l, int item, unsigned char* smem) {
  const int tid = TIDX, lane = tid & 63, wave = tid >> 6;
  const int grp = item & 3, ch = (item >> 2) & 15, b = item >> 6;
  const int tok0 = b * 2048 + ch * 128;
  u16* sWg = (u16*)smem;
  u16* sVT = sWg + 128 * 136;
  const float* wg = p.sg_w + ((size_t)(l * 4 + grp) * 128) * 128;
  const u16* vvb = (const u16*)(p.ws + W_VV);
  const u16* su = (const u16*)(p.ws + W_SU);
  u16* cat = (u16*)(p.ws + W_CAT);
#pragma unroll
  for (int i = 0; i < 16; ++i) {
    int idx = tid + 256 * i;
    int t = idx >> 5, s4 = (idx & 31) * 4;
    float4 w = *(const float4*)(wg + t * 128 + s4);
    if (s4 + 0 > t) w.x = 0.f;
    if (s4 + 1 > t) w.y = 0.f;
    if (s4 + 2 > t) w.z = 0.f;
    if (s4 + 3 > t) w.w = 0.f;
    uint2 o; o.x = pack2(w.x, w.y); o.y = pack2(w.z, w.w);
    *(uint2*)(sWg + t * 136 + s4) = o;
  }
#pragma unroll
  for (int i = 0; i < 8; ++i) {
    int idx = tid + 256 * i;
    int s = idx >> 4, c8 = (idx & 15) * 8;
    uint4 v = *(const uint4*)(vvb + (size_t)(tok0 + s) * 512 + grp * 128 + c8);
    u16 e[8];
    e[0] = v.x & 0xffff; e[1] = v.x >> 16; e[2] = v.y & 0xffff; e[3] = v.y >> 16;
    e[4] = v.z & 0xffff; e[5] = v.z >> 16; e[6] = v.w & 0xffff; e[7] = v.w >> 16;
#pragma unroll
    for (int j = 0; j < 8; ++j) sVT[(c8 + j) * 136 + s] = e[j];
  }
  __syncthreads();
  const int wm = wave & 1, wn = wave >> 1;
  f32x4 acc[4][4];
#pragma unroll
  for (int i = 0; i < 4; ++i)
#pragma unroll
    for (int j = 0; j < 4; ++j) acc[i][j] = (f32x4){0.f, 0.f, 0.f, 0.f};
#pragma unroll
  for (int ks = 0; ks < 4; ++ks) {
    bf16x8 a[4], bb[4];
#pragma unroll
    for (int i = 0; i < 4; ++i) a[i] = *(const bf16x8*)(sVT + (wm * 64 + i * 16 + (lane & 15)) * 136 + ks * 32 + (lane >> 4) * 8);
#pragma unroll
    for (int j = 0; j < 4; ++j) bb[j] = *(const bf16x8*)(sWg + (wn * 64 + j * 16 + (lane & 15)) * 136 + ks * 32 + (lane >> 4) * 8);
#pragma unroll
    for (int i = 0; i < 4; ++i)
#pragma unroll
      for (int j = 0; j < 4; ++j) acc[i][j] = __builtin_amdgcn_mfma_f32_16x16x32_bf16(a[i], bb[j], acc[i][j], 0, 0, 0);
  }
#pragma unroll
  for (int i = 0; i < 4; ++i)
#pragma unroll
    for (int j = 0; j < 4; ++j) {
      int c = wm * 64 + i * 16 + (lane >> 4) * 4;
      int t = wn * 64 + j * 16 + (lane & 15);
      float bias = p.sg_b[(l * 4 + grp) * 128 + t];
      uint2 uu = *(const uint2*)(su + (size_t)(tok0 + t) * 512 + grp * 128 + c);
      uint2 o;
      o.x = pack2((acc[i][j][0] + bias) * bflo(uu.x), (acc[i][j][1] + bias) * bfhi(uu.x));
      o.y = pack2((acc[i][j][2] + bias) * bflo(uu.y), (acc[i][j][3] + bias) * bfhi(uu.y));
      *(uint2*)(cat + (size_t)(tok0 + t) * 1024 + 512 + grp * 128 + c) = o;
    }
  __syncthreads();
}

__device__ void sgu_sample_block(const Params& p, int l, int item) {
  const int tid = TIDX;
  const int t = NPR + item, tp = item & 7;
  const int c = 2 * tid, grp = c >> 7;
  const u16* vvb = (const u16*)(p.ws + W_VV);
  const u16* su = (const u16*)(p.ws + W_SU);
  u16* cat = (u16*)(p.ws + W_CAT);
  const float* wr = p.sg_w + ((size_t)(l * 4 + grp) * 128 + tp) * 128;
  float a0 = 0.f, a1 = 0.f;
  for (int s = 0; s <= tp; ++s) {
    uint32_t u = *(const uint32_t*)(vvb + (size_t)(t - tp + s) * 512 + c);
    float w = wr[s];
    a0 += w * bflo(u); a1 += w * bfhi(u);
  }
  float bias = p.sg_b[(l * 4 + grp) * 128 + tp];
  uint32_t uu = *(const uint32_t*)(su + (size_t)t * 512 + c);
  *(uint32_t*)(cat + (size_t)t * 1024 + 512 + c) = pack2((a0 + bias) * bflo(uu), (a1 + bias) * bfhi(uu));
}

__device__ __forceinline__ int first_item(int lo) {
  const int G = gridDim.x;
  int r = ((int)blockIdx.x - lo) % G;
  if (r < 0) r += G;
  return lo + r;
}
__device__ void phase_mix(const Params& p, int l, unsigned char* smem) {
  const int lane = TIDX & 63, wave = TIDX >> 6;
  const int G = gridDim.x, bid = blockIdx.x;
  if (G > 256) {
    if (bid < 256) {
      __builtin_amdgcn_s_setprio(3);
      delta_prompt_wave(p, l, bid * 4 + wave, lane, smem);
      __builtin_amdgcn_s_setprio(0);
    } else {
      const int ob = bid - 256, on = G - 256;
      for (int it = ob; it < 512; it += on) delta_sample_block(p, l, it, smem);
      for (int it = ob; it < 512; it += on) sgu_prompt_block(p, l, it, smem);
      for (int it = ob; it < 1024; it += on) sgu_sample_block(p, l, it);
      convert_tables(p, ob, on, l, l + 1);
    }
  } else {
    for (int it = first_item(0); it < 256; it += G) { delta_prompt_wave(p, l, it * 4 + wave, lane, smem); __syncthreads(); }
    for (int it = first_item(256); it < 768; it += G) delta_sample_block(p, l, it - 256, smem);
    for (int it = first_item(768); it < 1280; it += G) sgu_prompt_block(p, l, it - 768, smem);
    for (int it = first_item(1280); it < 2304; it += G) sgu_sample_block(p, l, it - 1280);
  }
}

__device__ void phase_onorm(const Params& p, int l) {
  const int lane = TIDX & 63, gw = blockIdx.x * 4 + (TIDX >> 6), nw = gridDim.x * 4;
  const float* ob = (const float*)(p.ws + W_O);
  const u16* proj = (const u16*)(p.ws + W_PROJ);
  u16* cat = (u16*)(p.ws + W_CAT);
  for (int t = gw; t < NTOK; t += nw) {
#pragma unroll
    for (int h = 0; h < 4; ++h) {
      const int c = h * 128 + 2 * lane;
      float2 o = *(const float2*)(ob + (size_t)t * 512 + c);
      float ss = wave_sum(o.x * o.x + o.y * o.y);
      float r = rsqrtf(ss * (1.f / 128.f) + 1e-6f);
      float2 g = *(const float2*)(p.o_norm_g + l * 128 + 2 * lane);
      uint32_t z = *(const uint32_t*)(proj + (size_t)t * PIN + 1536 + c);
      *(uint32_t*)(cat + (size_t)t * 1024 + c) = pack2(o.x * r * g.x * silu_f(bflo(z)), o.y * r * g.y * silu_f(bfhi(z)));
    }
  }
}

__device__ void attn_prompt_block(const Params& p, int l, int item, unsigned char* smem) {
  const int tid = TIDX, lane = tid & 63, wave = tid >> 6;
  const int qt = item & 31, hd = (item >> 5) & 3, b = item >> 7;
  const int g = lane >> 4, li = lane & 15;
  constexpr int RS = 264;
  u16* bufs = (u16*)smem;
  const u16* qm = (const u16*)(p.ws + W_QM);
  const u16* mkb = (const u16*)(p.ws + W_MKB) + ((size_t)(l * 8 + b) * 256) * 1024 + hd * 256;
  const u16* mvt = (const u16*)(p.ws + W_MVT) + ((size_t)(l * 8 + b) * 1024 + hd * 256) * 256;
  u16* att = (u16*)(p.ws + W_ATT);
  const size_t tq = (size_t)b * 2048 + qt * 64 + wave * 16 + li;
  const int prow = tid >> 5, pcol = (tid & 31) * 8;
  uint4 c0, c1, c2, c3, c4, c5, c6, c7;
#define AP_LOAD(ch_) do { const u16* s_ = ((ch_) < 4) ? mkb + (size_t)((ch_) * 64 + prow) * 1024 + pcol : mvt + (size_t)(((ch_) - 4) * 64 + prow) * 256 + pcol; \
    const size_t rs_ = ((ch_) < 4) ? 8 * 1024 : 8 * 256; \
    c0 = *(const uint4*)(s_); c1 = *(const uint4*)(s_ + rs_); c2 = *(const uint4*)(s_ + 2 * rs_); c3 = *(const uint4*)(s_ + 3 * rs_); \
    c4 = *(const uint4*)(s_ + 4 * rs_); c5 = *(const uint4*)(s_ + 5 * rs_); c6 = *(const uint4*)(s_ + 6 * rs_); c7 = *(const uint4*)(s_ + 7 * rs_); } while (0)
#define AP_STORE(bi_) do { u16* d_ = bufs + (bi_) * 64 * RS + prow * RS + pcol; \
    *(uint4*)(d_) = c0; *(uint4*)(d_ + 8 * RS) = c1; *(uint4*)(d_ + 16 * RS) = c2; *(uint4*)(d_ + 24 * RS) = c3; \
    *(uint4*)(d_ + 32 * RS) = c4; *(uint4*)(d_ + 40 * RS) = c5; *(uint4*)(d_ + 48 * RS) = c6; *(uint4*)(d_ + 56 * RS) = c7; } while (0)
  AP_LOAD(0);
  bf16x8 qf[8];
#pragma unroll
  for (int ks = 0; ks < 8; ++ks) qf[ks] = *(const bf16x8*)(qm + tq * 1024 + hd * 256 + ks * 32 + g * 8);
  AP_STORE(0);
  AP_LOAD(1);
  __syncthreads();
  f32x4 st[16];
#pragma unroll
  for (int ch = 0; ch < 4; ++ch) {
    AP_STORE((ch + 1) & 1);
    AP_LOAD(ch + 2);
    const u16* cb = bufs + (ch & 1) * 64 * RS;
#pragma unroll
    for (int mt = 0; mt < 4; ++mt) {
      f32x4 acc = (f32x4){0.f, 0.f, 0.f, 0.f};
#pragma unroll
      for (int ks = 0; ks < 8; ++ks) {
        bf16x8 kf = *(const bf16x8*)(cb + (mt * 16 + li) * RS + ks * 32 + g * 8);
        acc = __builtin_amdgcn_mfma_f32_16x16x32_bf16(kf, qf[ks], acc, 0, 0, 0);
      }
      st[ch * 4 + mt] = acc;
    }
    __syncthreads();
  }
  float mx = -1e30f;
#pragma unroll
  for (int mt = 0; mt < 16; ++mt)
#pragma unroll
    for (int r = 0; r < 4; ++r) mx = fmaxf(mx, st[mt][r]);
  mx = fmaxf(mx, __shfl_xor(mx, 16, 64));
  mx = fmaxf(mx, __shfl_xor(mx, 32, 64));
  float sum = 0.f;
#pragma unroll
  for (int mt = 0; mt < 16; ++mt)
#pragma unroll
    for (int r = 0; r < 4; ++r) { float e = __expf((st[mt][r] - mx) * 0.0625f); st[mt][r] = e; sum += e; }
  sum += __shfl_xor(sum, 16, 64);
  sum += __shfl_xor(sum, 32, 64);
  const float inv = 1.f / sum;
  bf16x8 pf[8];
#pragma unroll
  for (int k2 = 0; k2 < 8; ++k2) {
    union { uint32_t u[4]; bf16x8 v; } r;
    r.u[0] = pack2(st[2 * k2][0], st[2 * k2][1]); r.u[1] = pack2(st[2 * k2][2], st[2 * k2][3]);
    r.u[2] = pack2(st[2 * k2 + 1][0], st[2 * k2 + 1][1]); r.u[3] = pack2(st[2 * k2 + 1][2], st[2 * k2 + 1][3]);
    pf[k2] = r.v;
  }
#pragma unroll
  for (int ch = 4; ch < 8; ++ch) {
    if (ch + 1 < 8) AP_STORE((ch + 1) & 1);
    if (ch + 2 < 8) AP_LOAD(ch + 2);
    const u16* cb = bufs + (ch & 1) * 64 * RS;
#pragma unroll
    for (int dtl = 0; dtl < 4; ++dtl) {
      f32x4 acc = (f32x4){0.f, 0.f, 0.f, 0.f};
      const u16* vr = cb + (dtl * 16 + li) * RS;
#pragma unroll
      for (int k2 = 0; k2 < 8; ++k2) {
        uint2 lo = *(const uint2*)(vr + k2 * 32 + 4 * g);
        uint2 hi = *(const uint2*)(vr + k2 * 32 + 16 + 4 * g);
        union { uint32_t u[4]; bf16x8 v; } r;
        r.u[0] = lo.x; r.u[1] = lo.y; r.u[2] = hi.x; r.u[3] = hi.y;
        acc = __builtin_amdgcn_mfma_f32_16x16x32_bf16(r.v, pf[k2], acc, 0, 0, 0);
      }
      uint2 o; o.x = pack2(acc[0] * inv, acc[1] * inv); o.y = pack2(acc[2] * inv, acc[3] * inv);
      *(uint2*)(att + tq * 1024 + hd * 256 + ((ch - 4) * 4 + dtl) * 16 + 4 * g) = o;
    }
    __syncthreads();
  }
}

__device__ void attn_sample_block(const Params& p, int l, int item, unsigned char* smem) {
  const int tid = TIDX, lane = tid & 63, wave = tid >> 6;
  const int hd = item & 3, b = item >> 2;
  const int g = lane >> 4, li = lane & 15;
  float* pl = (float*)smem;
  float* op = pl + 4 * 64 * 8;
  float* ml = op + 4 * 8 * 256;
  const u16* qm = (const u16*)(p.ws + W_QM);
  u16* att = (u16*)(p.ws + W_ATT);
  const size_t t0 = NPR + (size_t)b * 8;
  const float* kb = p.cache_mem_k + ((size_t)(l * 128 + b) * 256) * 1024 + hd * 256;
  const float* vb = p.cache_mem_v + ((size_t)(l * 128 + b) * 256) * 1024 + hd * 256;
  bf16x8 qf[8];
#pragma unroll
  for (int ks = 0; ks < 8; ++ks) {
    bf16x8 z = {0, 0, 0, 0, 0, 0, 0, 0};
    qf[ks] = (li < 8) ? *(const bf16x8*)(qm + (t0 + li) * 1024 + hd * 256 + ks * 32 + g * 8) : z;
  }
  f32x4 st[4];
#pragma unroll
  for (int mt = 0; mt < 4; ++mt) {
    const float* kr = kb + (size_t)(wave * 64 + mt * 16 + li) * 1024;
    f32x4 acc = (f32x4){0.f, 0.f, 0.f, 0.f};
#pragma unroll
    for (int ks = 0; ks < 8; ++ks) {
      float4 f0 = *(const float4*)(kr + ks * 32 + g * 8);
      float4 f1 = *(const float4*)(kr + ks * 32 + g * 8 + 4);
      acc = __builtin_amdgcn_mfma_f32_16x16x32_bf16(pack8(f0, f1), qf[ks], acc, 0, 0, 0);
    }
    st[mt] = acc;
  }
  float mx = -1e30f;
#pragma unroll
  for (int mt = 0; mt < 4; ++mt)
#pragma unroll
    for (int r = 0; r < 4; ++r) mx = fmaxf(mx, st[mt][r]);
  mx = fmaxf(mx, __shfl_xor(mx, 16, 64));
  mx = fmaxf(mx, __shfl_xor(mx, 32, 64));
  float sum = 0.f;
#pragma unroll
  for (int mt = 0; mt < 4; ++mt)
#pragma unroll
    for (int r = 0; r < 4; ++r) {
      float e = __expf((st[mt][r] - mx) * 0.0625f);
      sum += e;
      if (li < 8) pl[(wave * 64 + mt * 16 + 4 * g + r) * 8 + li] = e;
    }
  sum += __shfl_xor(sum, 16, 64);
  sum += __shfl_xor(sum, 32, 64);
  if (lane < 8) { ml[(wave * 8 + lane) * 2] = mx; ml[(wave * 8 + lane) * 2 + 1] = sum; }
  __syncthreads();
  {
    float4 acc[8];
#pragma unroll
    for (int q = 0; q < 8; ++q) acc[q] = make_float4(0.f, 0.f, 0.f, 0.f);
    float4 vcur[8], vnxt[8];
#pragma unroll
    for (int u = 0; u < 8; ++u) vcur[u] = ((const float4*)(vb + (size_t)(wave * 64 + u) * 1024))[lane];
#pragma unroll 1
    for (int k0 = 0; k0 < 64; k0 += 8) {
      if (k0 + 8 < 64) {
#pragma unroll
        for (int u = 0; u < 8; ++u) vnxt[u] = ((const float4*)(vb + (size_t)(wave * 64 + k0 + 8 + u) * 1024))[lane];
      }
#pragma unroll
      for (int u = 0; u < 8; ++u) {
        const float4 v = vcur[u];
        float4 pa = *(const float4*)(pl + (wave * 64 + k0 + u) * 8);
        float4 pb = *(const float4*)(pl + (wave * 64 + k0 + u) * 8 + 4);
        float pp[8] = {pa.x, pa.y, pa.z, pa.w, pb.x, pb.y, pb.z, pb.w};
#pragma unroll
        for (int q = 0; q < 8; ++q) {
          acc[q].x += pp[q] * v.x; acc[q].y += pp[q] * v.y; acc[q].z += pp[q] * v.z; acc[q].w += pp[q] * v.w;
        }
      }
#pragma unroll
      for (int u = 0; u < 8; ++u) vcur[u] = vnxt[u];
    }
#pragma unroll
    for (int q = 0; q < 8; ++q) *(float4*)(op + (wave * 8 + q) * 256 + lane * 4) = acc[q];
  }
  __syncthreads();
  {
    const int d = tid;
#pragma unroll
    for (int q = 0; q < 8; ++q) {
      float M = fmaxf(fmaxf(ml[(0 * 8 + q) * 2], ml[(1 * 8 + q) * 2]), fmaxf(ml[(2 * 8 + q) * 2], ml[(3 * 8 + q) * 2]));
      float den = 0.f, num = 0.f;
#pragma unroll
      for (int w = 0; w < 4; ++w) {
        float f = __expf((ml[(w * 8 + q) * 2] - M) * 0.0625f);
        den += f * ml[(w * 8 + q) * 2 + 1];
        num += f * op[(w * 8 + q) * 256 + d];
      }
      att[(t0 + q) * 1024 + hd * 256 + d] = f2bf(num / den);
    }
  }
  __syncthreads();
}

__device__ void phase_attn(const Params& p, int l, unsigned char* smem) {
  const int G = gridDim.x, b0 = blockIdx.x;
  if (b0 & 1) {
    for (int it = b0; it < 512 + 1024; it += G) if (it >= 512) attn_prompt_block(p, l, it - 512, smem);
    for (int it = b0; it < 512; it += G) attn_sample_block(p, l, it, smem);
  } else {
    for (int it = b0; it < 512 + 1024; it += G) {
      if (it < 512) attn_sample_block(p, l, it, smem);
      else attn_prompt_block(p, l, it - 512, smem);
    }
  }
}

__device__ __forceinline__ void ins16(float (&L)[16], float x) {
#pragma unroll
  for (int j = 0; j < 16; ++j) { float hi = __builtin_fmaxf(L[j], x); x = __builtin_fminf(L[j], x); L[j] = hi; }
}
__device__ void phase_route(const Params& p, int l, unsigned char* smem) {
  const int tid = TIDX, lane = tid & 63, wave = tid >> 6;
  const int g = lane >> 4, li = lane & 15;
  float* s = (float*)smem;
  float* lv = (float*)(smem + 66560);
  const u16* pq = (const u16*)(p.ws + W_PQ);
  const u16* keyb = (const u16*)(p.ws + W_KEYB);
  int* eidx = (int*)(p.ws + W_EIDX);
  float* gate = (float*)(p.ws + W_GATE);
  for (int it = blockIdx.x; it < 272 * 8; it += gridDim.x) {
    const int hd = it & 7, tt = it >> 3;
    const int t0 = tt * 64;
#pragma unroll 1
    for (int ph = 0; ph < 2; ++ph) {
      bf16x8 qf[2];
#pragma unroll
      for (int ks = 0; ks < 2; ++ks)
        qf[ks] = *(const bf16x8*)(pq + (size_t)(t0 + wave * 16 + li) * 1024 + hd * 128 + ph * 64 + ks * 32 + g * 8);
      const u16* kb = keyb + ((size_t)((l * 8 + hd) * 2 + ph) * 128) * 64;
#pragma unroll
      for (int nt = 0; nt < 8; ++nt) {
        f32x4 acc = (f32x4){0.f, 0.f, 0.f, 0.f};
#pragma unroll
        for (int ks = 0; ks < 2; ++ks) {
          bf16x8 kf = *(const bf16x8*)(kb + (size_t)(nt * 16 + li) * 64 + ks * 32 + g * 8);
          acc = __builtin_amdgcn_mfma_f32_16x16x32_bf16(kf, qf[ks], acc, 0, 0, 0);
        }
        float* dst = s + (size_t)(ph * 64 + wave * 16 + li) * 130 + (nt >> 2) * 65 + (nt & 3) * 16 + 4 * g;
        dst[0] = acc[0]; dst[1] = acc[1]; dst[2] = acc[2]; dst[3] = acc[3];
      }
    }
    __syncthreads();
    {
      const int row = tid >> 1, hr = tid & 1;
      const float* rp = s + (size_t)row * 130 + hr * 65;
      float L[16];
#pragma unroll
      for (int j = 0; j < 16; ++j) L[j] = -3.0e38f;
#pragma unroll 4
      for (int k = 0; k < 64; ++k) {
        float v = rp[k];
        float x = __uint_as_float((__float_as_uint(v) & ~0x7fu) | (unsigned)(hr * 64 + k));
        ins16(L, x);
      }
      float P[16];
#pragma unroll
      for (int j = 0; j < 16; ++j) P[j] = dpp_f<0xB1>(L[j]);
#pragma unroll
      for (int j = 0; j < 16; ++j) ins16(L, P[j]);
      if (hr == 0) {
#pragma unroll
        for (int j = 0; j < 4; ++j) *(float4*)(lv + row * 16 + 4 * j) = make_float4(L[4 * j], L[4 * j + 1], L[4 * j + 2], L[4 * j + 3]);
      }
    }
    __syncthreads();
    if (tid < 64) {
      const float* v1 = lv + tid * 16;
      const float* v2 = lv + (64 + tid) * 16;
      float a1[16], a2[16];
#pragma unroll
      for (int j = 0; j < 16; ++j) {
        a1[j] = __uint_as_float(__float_as_uint(v1[j]) & ~0x7fu);
        a2[j] = __uint_as_float(__float_as_uint(v2[j]) & ~0x7fu);
      }
      float C[16];
#pragma unroll
      for (int j = 0; j < 16; ++j) C[j] = -3.0e38f;
#pragma unroll
      for (int i = 0; i < 16; ++i) {
#pragma unroll
        for (int j = 0; j < 16 / (i + 1); ++j) {
          float c = a1[i] + a2[j];
          ins16(C, __uint_as_float((__float_as_uint(c) & ~0xffu) | (unsigned)(i * 16 + j)));
        }
      }
      const float m = __uint_as_float(__float_as_uint(C[0]) & ~0xffu);
      float ex[16]; int ee[16]; float sum = 0.f;
#pragma unroll
      for (int k = 0; k < 16; ++k) {
        const unsigned bits = __float_as_uint(C[k]);
        const int id = bits & 0xff;
        ex[k] = __expf(__uint_as_float(bits & ~0xffu) - m);
        sum += ex[k];
        const int i1 = __float_as_uint(v1[id >> 4]) & 0x7f, i2 = __float_as_uint(v2[id & 15]) & 0x7f;
        ee[k] = i1 * 128 + i2;
      }
      const float inv = 1.f / sum;
      const size_t ob = (size_t)(t0 + tid) * 128 + hd * 16;
#pragma unroll
      for (int k = 0; k < 4; ++k) {
        *(int4*)(eidx + ob + 4 * k) = make_int4(ee[4 * k], ee[4 * k + 1], ee[4 * k + 2], ee[4 * k + 3]);
        *(float4*)(gate + ob + 4 * k) = make_float4(ex[4 * k] * inv, ex[4 * k + 1] * inv, ex[4 * k + 2] * inv, ex[4 * k + 3] * inv);
      }
    }
    __syncthreads();
  }
}

typedef __attribute__((ext_vector_type(2))) float f32x2;
__device__ __forceinline__ float peer_dot16(const uint4 ua, const float (&x)[16]) {
  const uint32_t w[4] = {ua.x, ua.y, ua.z, ua.w};
  float d0 = 0.f, d1 = 0.f;
#pragma unroll
  for (int j = 0; j < 4; ++j) {
    f32x2 lo = __builtin_amdgcn_cvt_pk_f32_fp8((int)w[j], false);
    f32x2 hi = __builtin_amdgcn_cvt_pk_f32_fp8((int)w[j], true);
    d0 += lo[0] * x[4 * j] + hi[0] * x[4 * j + 2];
    d1 += lo[1] * x[4 * j + 1] + hi[1] * x[4 * j + 3];
  }
  return d0 + d1;
}
__device__ __forceinline__ void peer_axpy16(float (&acc)[16], const uint4 va, const float ck) {
  const uint32_t w[4] = {va.x, va.y, va.z, va.w};
#pragma unroll
  for (int j = 0; j < 4; ++j) {
    f32x2 lo = __builtin_amdgcn_cvt_pk_f32_fp8((int)w[j], false);
    f32x2 hi = __builtin_amdgcn_cvt_pk_f32_fp8((int)w[j], true);
    acc[4 * j] += ck * lo[0]; acc[4 * j + 1] += ck * lo[1]; acc[4 * j + 2] += ck * hi[0]; acc[4 * j + 3] += ck * hi[1];
  }
}
__device__ __forceinline__ void pe_load(uint4 (&U)[8], const unsigned char* tab, int e_lo, int e_hi, int it, int lane) {
  const int ev = (it < 8) ? e_lo : e_hi;
#pragma unroll
  for (int k = 0; k < 8; ++k) {
    const int e = __builtin_amdgcn_readlane(ev, (it & 7) * 8 + k);
    U[k] = ((const uint4*)(tab + (size_t)e * 1024))[lane];
  }
}
__device__ __forceinline__ void pe_half(uint4 (&UC)[8], uint4 (&VC)[8], float (&acc)[16], const float (&x)[16], const unsigned char* ub,
                                        const unsigned char* vb, const float* gate, int e_lo, int e_hi, int t, int it, int lane, int klocal) {
  pe_load(VC, vb, e_lo, e_hi, it, lane);
  const float gt = gate[(size_t)t * 128 + it * 8 + klocal];
  float pp[8];
#pragma unroll
  for (int k = 0; k < 8; ++k) pp[k] = peer_dot16(UC[k], x);
  if (it + 1 < 16) pe_load(UC, ub, e_lo, e_hi, it + 1, lane);
  float r4[4], r2[2], r1;
  {
    const bool up = lane & 32;
#pragma unroll
    for (int i = 0; i < 4; ++i) { float keep = up ? pp[i + 4] : pp[i]; float send = up ? pp[i] : pp[i + 4]; r4[i] = keep + __shfl_xor(send, 32, 64); }
  }
  {
    const bool up = lane & 16;
#pragma unroll
    for (int i = 0; i < 2; ++i) { float keep = up ? r4[i + 2] : r4[i]; float send = up ? r4[i] : r4[i + 2]; r2[i] = keep + __shfl_xor(send, 16, 64); }
  }
  {
    const bool up = lane & 8;
    float keep = up ? r2[1] : r2[0]; float send = up ? r2[0] : r2[1];
    r1 = keep + __shfl_xor(send, 8, 64);
  }
  r1 += dpp_f<0x4E>(r1);
  r1 += dpp_f<0xB1>(r1);
  r1 += __shfl_xor(r1, 4, 64);
  const float coef = gt * gelu_t(r1 * (1.f / 128.f)) * (1.f / 64.f);
#pragma unroll
  for (int k = 0; k < 8; ++k) {
    const int sl = ((k >> 2) & 1) * 32 + ((k >> 1) & 1) * 16 + (k & 1) * 8;
    const float ck = __int_as_float(__builtin_amdgcn_readlane(__float_as_int(coef), sl));
    peer_axpy16(acc, VC[k], ck);
  }
}
__device__ void phase_peer(const Params& p, int l) {
  const int lane = TIDX & 63, gw = blockIdx.x * 4 + (TIDX >> 6), nw = gridDim.x * 4;
  const u16* nbuf = (const u16*)(p.ws + W_NB);
  u16* nbw = (u16*)(p.ws + W_NB);
  float* h = (float*)(p.ws + W_H);
  const int* eidx = (const int*)(p.ws + W_EIDX);
  const float* gate = (const float*)(p.ws + W_GATE);
  const unsigned char* ub = p.ws + W_UB + (size_t)l * 16384 * 1024;
  const unsigned char* vb = p.ws + W_VB + (size_t)l * 16384 * 1024;
  const int klocal = ((lane >> 5) & 1) * 4 + ((lane >> 4) & 1) * 2 + ((lane >> 3) & 1);
  for (int tw = gw; tw < NTOK; tw += nw) {
    const int t = __builtin_amdgcn_readfirstlane(tw);
    const int e_lo = eidx[(size_t)t * 128 + lane], e_hi = eidx[(size_t)t * 128 + 64 + lane];
    float x[16];
    {
      const float* hr0 = h + (size_t)t * 1024 + 16 * lane;
      const float* gf = p.norm_ffn_g + l * 1024 + 16 * lane;
      float ss0 = 0.f;
#pragma unroll
      for (int j = 0; j < 4; ++j) {
        float4 a = *(const float4*)(hr0 + 4 * j);
        x[4 * j] = a.x; x[4 * j + 1] = a.y; x[4 * j + 2] = a.z; x[4 * j + 3] = a.w;
        ss0 += a.x * a.x + a.y * a.y + a.z * a.z + a.w * a.w;
      }
      ss0 = wave_sum(ss0);
      const float r0 = rsqrtf(ss0 * (1.f / 1024.f) + 1e-6f);
#pragma unroll
      for (int j = 0; j < 4; ++j) {
        float4 gq = *(const float4*)(gf + 4 * j);
        x[4 * j] *= r0 * gq.x; x[4 * j + 1] *= r0 * gq.y; x[4 * j + 2] *= r0 * gq.z; x[4 * j + 3] *= r0 * gq.w;
      }
    }
    float acc[16];
#pragma unroll
    for (int i = 0; i < 16; ++i) acc[i] = 0.f;
    uint4 ua[8], va[8];
    pe_load(ua, ub, e_lo, e_hi, 0, lane);
#pragma unroll 1
    for (int it = 0; it < 16; ++it) pe_half(ua, va, acc, x, ub, vb, gate, e_lo, e_hi, t, it, lane, klocal);
    float* hr = h + (size_t)t * 1024 + 16 * lane;
    float hv[16];
#pragma unroll
    for (int j = 0; j < 4; ++j) {
      float4 a = *(const float4*)(hr + 4 * j);
      hv[4 * j] = a.x + acc[4 * j]; hv[4 * j + 1] = a.y + acc[4 * j + 1]; hv[4 * j + 2] = a.z + acc[4 * j + 2]; hv[4 * j + 3] = a.w + acc[4 * j + 3];
    }
    float ss = 0.f;
#pragma unroll
    for (int i = 0; i < 16; ++i) ss += hv[i] * hv[i];
    ss = wave_sum(ss);
    const float r = rsqrtf(ss * (1.f / 1024.f) + 1e-6f);
    const float* gsrc = ((l == 1) ? p.final_norm_g : p.norm_mix_g + 1024) + 16 * lane;
    float yv[16];
#pragma unroll
    for (int j = 0; j < 4; ++j) {
      float4 gq = *(const float4*)(gsrc + 4 * j);
      yv[4 * j] = hv[4 * j] * r * gq.x; yv[4 * j + 1] = hv[4 * j + 1] * r * gq.y; yv[4 * j + 2] = hv[4 * j + 2] * r * gq.z; yv[4 * j + 3] = hv[4 * j + 3] * r * gq.w;
    }
    if (l == 1) {
      float* yo = ((t < NPR) ? p.out + O_YP + (size_t)t * 1024 : p.out + O_YS + (size_t)(t - NPR) * 1024) + 16 * lane;
#pragma unroll
      for (int j = 0; j < 4; ++j) *(float4*)(yo + 4 * j) = make_float4(yv[4 * j], yv[4 * j + 1], yv[4 * j + 2], yv[4 * j + 3]);
    } else {
#pragma unroll
      for (int j = 0; j < 4; ++j) *(float4*)(hr + 4 * j) = make_float4(hv[4 * j], hv[4 * j + 1], hv[4 * j + 2], hv[4 * j + 3]);
      u16* nd = nbw + (size_t)t * 1024 + 16 * lane;
      *(uint4*)nd = make_uint4(pack2(yv[0], yv[1]), pack2(yv[2], yv[3]), pack2(yv[4], yv[5]), pack2(yv[6], yv[7]));
      *(uint4*)(nd + 8) = make_uint4(pack2(yv[8], yv[9]), pack2(yv[10], yv[11]), pack2(yv[12], yv[13]), pack2(yv[14], yv[15]));
    }
  }
}

__global__ void __launch_bounds__(256, 2) mega(Params p) {
  __shared__ __attribute__((aligned(16))) unsigned char smem[SMEM_BYTES];
  cg::grid_group grid = cg::this_grid();
  __shared__ uint4 xb_words;
  if (threadIdx.x == 0) xb_words = make_uint4(0u, 0u, 0u, 0u);
  __syncthreads();
  XcdBarrier xb = xcd_barrier_post((unsigned*)(p.ws + W_BAR), (volatile LAS unsigned*)&xb_words);
  phase0a(p, smem);
  if (p.out == nullptr) grid.sync();
  xcd_barrier(xb);
  float* h = (float*)(p.ws + W_H);
  const u16* nbuf = (const u16*)(p.ws + W_NB);
  for (int l = 0; l < 2; ++l) {
    const u16* WT = (const u16*)(p.ws + W_WT) + (size_t)l * WTROWS * 1024;
    phase_g1(p, l, smem);
    xcd_barrier(xb);
    if (PROBE_DUP == 1) { phase_g1(p, l, smem); xcd_barrier(xb); }
    phase_prep(p, l, smem);
    xcd_barrier(xb);
    if (PROBE_DUP == 2) { phase_prep(p, l, smem); xcd_barrier(xb); }
    phase_mix(p, l, smem);
    xcd_barrier(xb);
    if (PROBE_DUP == 3) { phase_mix(p, l, smem); xcd_barrier(xb); }
    phase_onorm(p, l);
    xcd_barrier(xb);
    if (PROBE_DUP == 7) { phase_onorm(p, l); xcd_barrier(xb); }
    {
      EpiRes e{l == 0 ? p.x_prompt : h, l == 0 ? p.x_sample : h + (size_t)NPR * 1024, h, (u16*)(p.ws + W_NB), (float*)(p.ws + W_PART), p.norm_mem_g + l * 1024};
      phase_gemm1024((const u16*)(p.ws + W_CAT), WT + (size_t)3200 * 1024, smem, e);
    }
    xcd_barrier(xb);
    {
      EpiBF16Rstd e{(u16*)(p.ws + W_QM), 1024, 1024, (const float*)(p.ws + W_PART)};
      phase_gemm1024(nbuf, WT + (size_t)4224 * 1024, smem, e);
    }
    xcd_barrier(xb);
    phase_attn(p, l, smem);
    xcd_barrier(xb);
    if (PROBE_DUP == 4) { phase_attn(p, l, smem); xcd_barrier(xb); }
    {
      EpiRes e{h, h + (size_t)NPR * 1024, h, (u16*)(p.ws + W_NB), (float*)(p.ws + W_PART), p.norm_ffn_g + l * 1024};
      phase_gemm1024((const u16*)(p.ws + W_ATT), WT + (size_t)5248 * 1024, smem, e);
    }
    xcd_barrier(xb);
    {
      EpiBF16Rstd e{(u16*)(p.ws + W_PQ), 1024, 1024, (const float*)(p.ws + W_PART)};
      phase_gemm1024(nbuf, WT + (size_t)6272 * 1024, smem, e);
    }
    xcd_barrier(xb);
    phase_route(p, l, smem);
    xcd_barrier(xb);
    if (PROBE_DUP == 5) { phase_route(p, l, smem); xcd_barrier(xb); }
    phase_peer(p, l);
    xcd_barrier(xb);
    if (PROBE_DUP == 6 && l == 1) { phase_peer(p, l); xcd_barrier(xb); }
  }
}

extern "C" void kernel_launch(void* const* d_in, const int* in_sizes, int n_in, void* d_out, int out_size, void* d_ws,
                              size_t ws_size, hipStream_t stream) {
  static int grid_blocks = 0;
  if (!grid_blocks) {
    int dev = 0, cus = 0, per_cu = 0;
    hipGetDevice(&dev);
    hipDeviceGetAttribute(&cus, hipDeviceAttributeMultiprocessorCount, dev);
    hipOccupancyMaxActiveBlocksPerMultiprocessor(&per_cu, mega, 256, 0);
    if (per_cu > 2) per_cu = 2;
    if (per_cu < 1) per_cu = 1;
    grid_blocks = cus * per_cu;
  }
  Params p{};
  const float** pp = (const float**)&p;
  for (int i = 0; i < 30; ++i) pp[i] = (const float*)d_in[i];
  p.out = (float*)d_out;
  p.ws = (unsigned char*)d_ws;
  hipMemsetAsync((unsigned char*)d_ws + W_BAR, 0, XCD_BAR_WORDS * 4, stream);
  void* args[] = {&p};
  hipError_t e = hipLaunchCooperativeKernel((void*)mega, dim3(grid_blocks), dim3(256), args, 0, stream);
  if (e != hipSuccess) fprintf(stderr, "cooperative launch failed: %s (grid %d)\n", hipGetErrorString(e), grid_blocks);
}
```

```cpp
#include <hip/hip_runtime.h>
#include <hip/hip_cooperative_groups.h>
#include <stdint.h>
#include <cstdio>
namespace cg = cooperative_groups;

typedef unsigned short u16;
typedef __attribute__((ext_vector_type(8))) short bf16x8;
typedef __attribute__((ext_vector_type(4))) float f32x4;
typedef __attribute__((ext_vector_type(2))) __bf16 bf2_t;

#define NTOK 17408
#define NPR 16384
#define PIN 3080
#define WTROWS 9344

constexpr size_t O_YP = 0;
constexpr size_t O_YS = 16777216;
constexpr size_t O_SDP = 17825792;
constexpr size_t O_SCP = 18874368;
constexpr size_t O_MKP = 18948096;
constexpr size_t O_MVP = 23142400;
constexpr size_t O_SDS = 27336704;
constexpr size_t O_SCS = 44113920;
constexpr size_t O_VRS = 45293568;

constexpr size_t W_WT = 0;
constexpr size_t W_UB = W_WT + 2ull * WTROWS * 1024 * 2;
constexpr size_t W_VB = W_UB + 2ull * 16384 * 1024 * 2;
constexpr size_t W_H = W_VB + 2ull * 16384 * 1024 * 2;
constexpr size_t W_NB = W_H + (size_t)NTOK * 1024 * 4;
constexpr size_t W_PROJ = W_NB + (size_t)NTOK * 1024 * 2;
constexpr size_t W_QKV = W_PROJ + (size_t)NTOK * PIN * 2;
constexpr size_t W_BG = W_QKV + (size_t)NTOK * 1536 * 2;
constexpr size_t W_SU = W_BG + (size_t)NTOK * 12 * 4;
constexpr size_t W_VV = W_SU + (size_t)NTOK * 512 * 2;
constexpr size_t W_O = W_VV + (size_t)NTOK * 512 * 2;
constexpr size_t W_CAT = W_O + (size_t)NTOK * 512 * 4;
constexpr size_t W_QM = W_CAT + (size_t)NTOK * 1024 * 2;
constexpr size_t W_ATT = W_QM + (size_t)NTOK * 1024 * 2;
constexpr size_t W_PQ = W_ATT + (size_t)NTOK * 1024 * 2;
constexpr size_t W_EIDX = W_PQ + (size_t)NTOK * 1024 * 4;
constexpr size_t W_GATE = W_EIDX + (size_t)NTOK * 128 * 4;
constexpr size_t W_MEMN = W_GATE + (size_t)NTOK * 128 * 4;
constexpr size_t W_MKB = W_MEMN + 2ull * 2048 * 1024 * 2;
constexpr size_t W_MVT = W_MKB + 2ull * 2048 * 1024 * 2;
constexpr size_t W_END = W_MVT + 2ull * 2048 * 1024 * 2;
constexpr size_t W_BAR = W_END;
constexpr size_t W_KEYB = W_END + 16384;
constexpr size_t W_PART = W_KEYB + (1u << 20);

struct Params {
  const float *x_prompt, *x_sample, *state_delta, *state_conv, *cache_mem_k, *cache_mem_v, *mem_prompt;
  const float *w_in, *conv_w, *a_log, *dt_bias, *o_norm_g, *sg_ln_g, *sg_ln_b, *sg_w, *sg_b, *w_out;
  const float *norm_mix_g, *norm_mem_g, *mem_norm_g, *w_mq, *w_mk, *w_mv, *w_mo, *norm_ffn_g;
  const float *peer_wq, *peer_keys, *peer_u, *peer_v, *final_norm_g;
  float* out;
  unsigned char* ws;
};

#define SMEM_BYTES 77824
#ifndef PROBE_DUP
#define PROBE_DUP 0
#endif

__device__ __forceinline__ u16 f2bf(float f) {
  uint32_t u = __float_as_uint(f);
  u += 0x7fffu + ((u >> 16) & 1u);
  return (u16)(u >> 16);
}
__device__ __forceinline__ float bf2f(u16 h) { return __uint_as_float(((uint32_t)h) << 16); }
__device__ __forceinline__ uint32_t pack2(float a, float b) { return (uint32_t)f2bf(a) | ((uint32_t)f2bf(b) << 16); }
__device__ __forceinline__ float bflo(uint32_t u) { return __uint_as_float(u << 16); }
__device__ __forceinline__ float bfhi(uint32_t u) { return __uint_as_float(u & 0xffff0000u); }
__device__ __forceinline__ float wave_sum(float v) {
#pragma unroll
  for (int o = 32; o > 0; o >>= 1) v += __shfl_xor(v, o, 64);
  return v;
}
__device__ __forceinline__ int opq(int x) { asm volatile("" : "+v"(x)); return x; }
#define TIDX opq((int)threadIdx.x)
__device__ __forceinline__ float gelu_t(float x) {
  float e2 = -2.302208198144199f * (x + 0.044715f * x * x * x);
  e2 = fminf(e2, 80.f);
  return x * __builtin_amdgcn_rcpf(1.f + __builtin_amdgcn_exp2f(e2));
}
__device__ __forceinline__ float silu_f(float x) {
  const float e2 = fminf(-1.4426950408889634f * x, 80.f);
  return x * __builtin_amdgcn_rcpf(1.f + __builtin_amdgcn_exp2f(e2));
}
__device__ __forceinline__ float dot2bf(uint32_t a, uint32_t b, float c) {
  return __builtin_amdgcn_fdot2_f32_bf16(__builtin_bit_cast(bf2_t, a), __builtin_bit_cast(bf2_t, b), c, false);
}
__device__ __forceinline__ bf16x8 pack8(float4 a, float4 b) {
  union { uint32_t u[4]; bf16x8 v; } r;
  r.u[0] = pack2(a.x, a.y); r.u[1] = pack2(a.z, a.w); r.u[2] = pack2(b.x, b.y); r.u[3] = pack2(b.z, b.w);
  return r.v;
}
__device__ __forceinline__ float4 ldnt4(const float4* p) {
  typedef __attribute__((ext_vector_type(4))) float v4f;
  v4f v = __builtin_nontemporal_load((const v4f*)p);
  return make_float4(v[0], v[1], v[2], v[3]);
}
__device__ __forceinline__ const float* hsrc(const float* p0, const float* p1, int m) {
  return (m < NPR) ? p0 + (size_t)m * 1024 : p1 + (size_t)(m - NPR) * 1024;
}

__device__ __forceinline__ void rms_row_bf16(const float* src, const float* g, u16* dst, int lane) {
  float4 v[4];
  float ss = 0.f;
#pragma unroll
  for (int i = 0; i < 4; ++i) {
    v[i] = ((const float4*)src)[lane + 64 * i];
    ss += v[i].x * v[i].x + v[i].y * v[i].y + v[i].z * v[i].z + v[i].w * v[i].w;
  }
  ss = wave_sum(ss);
  float r = rsqrtf(ss * (1.f / 1024.f) + 1e-6f);
#pragma unroll
  for (int i = 0; i < 4; ++i) {
    float4 gg = ((const float4*)g)[lane + 64 * i];
    uint2 o;
    o.x = pack2(v[i].x * r * gg.x, v[i].y * r * gg.y);
    o.y = pack2(v[i].z * r * gg.z, v[i].w * r * gg.w);
    ((uint2*)dst)[lane + 64 * i] = o;
  }
}

#define XB_TMO      128
#define XB_XCNT(j)  (256  + 64 * (j))
#define XB_XSUB(j)  (1280 + 64 * (j))
#define XB_XGEN(j)  (2304 + 64 * (j))
#define XB_TOP      3328
#define XB_TOPGEN   3392
#define XCD_BAR_WORDS 3456
#define XB_SPIN_CAP (1u << 22)
#define LAS __attribute__((address_space(3)))
__device__ __forceinline__ unsigned xb_ld(unsigned* p) { return __hip_atomic_load(p, __ATOMIC_RELAXED, __HIP_MEMORY_SCOPE_AGENT); }
__device__ __forceinline__ unsigned xb_add(unsigned* p, unsigned v) { return __hip_atomic_fetch_add(p, v, __ATOMIC_RELAXED, __HIP_MEMORY_SCOPE_AGENT); }
__device__ __forceinline__ unsigned xb_xcc_id() { return (unsigned)__builtin_amdgcn_s_getreg((3 << 11) | 20) & 0xFu; }
#define XB_SPIN(cond, bar) do { unsigned _sp = 0; while (cond) { __builtin_amdgcn_s_sleep(1); \
    if ((++_sp & 255u) == 0u) { if (xb_ld(&(bar)[XB_TMO])) break; if (_sp > XB_SPIN_CAP) { atomicAdd(&(bar)[XB_TMO], 1u); break; } } } } while (0)
struct XcdBarrier { unsigned* bar; unsigned x; volatile LAS unsigned* st; };
__device__ __forceinline__ XcdBarrier xcd_barrier_post(unsigned* bar, volatile LAS unsigned* st) {
  XcdBarrier b; b.bar = bar; b.x = xb_xcc_id(); b.st = st;
  if (threadIdx.x == 0) (void)xb_add(&bar[XB_XCNT(b.x)], 1u);
  return b;
}
__device__ __forceinline__ void xcd_barrier_complete(unsigned* bar, unsigned x, unsigned& nloc, unsigned& nx) {
  const unsigned G = gridDim.x * gridDim.y * gridDim.z;
  unsigned sum, cnt, mine, sp = 0u;
  for (;;) {
    sum = 0u; cnt = 0u; mine = 0u;
#pragma unroll
    for (unsigned j = 0; j < 16; ++j) { const unsigned c = xb_ld(&bar[XB_XCNT(j)]); sum += c; cnt += (c > 0u) ? 1u : 0u; mine = (j == x) ? c : mine; }
    if (sum == G) break;
    __builtin_amdgcn_s_sleep(1);
    if ((++sp & 255u) == 0u) { if (xb_ld(&bar[XB_TMO])) break; if (sp > XB_SPIN_CAP) { atomicAdd(&bar[XB_TMO], 1u); break; } }
  }
  nloc = mine > 0u ? mine : 1u; nx = cnt > 0u ? cnt : 1u;
}
__device__ __forceinline__ void xcd_barrier(const XcdBarrier& b) {
  asm volatile("s_waitcnt vmcnt(0)" ::: "memory");
  __syncthreads();
  if (threadIdx.x == 0) {
    unsigned* bar = b.bar;
    __builtin_amdgcn_s_waitcnt(0);
    unsigned nloc = b.st[0], nx = b.st[1];
    if (nloc == 0u) { xcd_barrier_complete(bar, b.x, nloc, nx); b.st[0] = nloc; b.st[1] = nx; }
    const unsigned old = xb_add(&bar[XB_XSUB(b.x)], 1u);
    const unsigned gen = old / nloc;
    if (old + 1u == (gen + 1u) * nloc) {
      __builtin_amdgcn_fence(__ATOMIC_RELEASE, "agent");
      asm volatile("s_waitcnt vmcnt(0)" ::: "memory");
      const unsigned og = xb_add(&bar[XB_TOP], 1u);
      const unsigned tg = og / nx;
      if (og + 1u == (tg + 1u) * nx) xb_add(&bar[XB_TOPGEN], 1u);
      else XB_SPIN(xb_ld(&bar[XB_TOPGEN]) == tg, bar);
      __builtin_amdgcn_fence(__ATOMIC_ACQUIRE, "agent");
      xb_add(&bar[XB_XGEN(b.x)], 1u);
      asm volatile("s_waitcnt vmcnt(0)" ::: "memory");
    } else {
      XB_SPIN(xb_ld(&bar[XB_XGEN(b.x)]) == gen, bar);
      __builtin_amdgcn_fence(__ATOMIC_ACQUIRE, "agent");
      asm volatile("s_waitcnt vmcnt(0)" ::: "memory");
    }
  }
  __syncthreads();
}
template <int CTRL> __device__ __forceinline__ float dpp_f(float v) {
  return __int_as_float(__builtin_amdgcn_update_dpp(0, __float_as_int(v), CTRL, 0xf, 0xf, true));
}
__device__ __forceinline__ float row_sum16(float v) {
  v += dpp_f<0xB1>(v);
  v += dpp_f<0x4E>(v);
  v += dpp_f<0x141>(v);
  v += dpp_f<0x140>(v);
  return v;
}

template <class Epi>
__device__ __forceinline__ void gemm_tile(const u16* X, const u16* W, int m0, int n0, u16* lds, const Epi& epi) {
  const int tid = TIDX, lane = tid & 63, wave = tid >> 6;
  const int wm = wave & 1, wn = wave >> 1;
  u16* sX = lds;
  u16* sW = lds + 2 * 128 * 64;
  f32x4 acc[4][4];
#pragma unroll
  for (int i = 0; i < 4; ++i)
#pragma unroll
    for (int j = 0; j < 4; ++j) acc[i][j] = (f32x4){0.f, 0.f, 0.f, 0.f};
  const int lrow = tid >> 3, lcol = (tid & 7) * 8;
  const u16* gx = X + (size_t)(m0 + lrow) * 1024 + lcol;
  const u16* gw = W + (size_t)(n0 + lrow) * 1024 + lcol;
  const int lo = lrow * 64 + (((tid & 7) ^ ((lrow >> 1) & 7)) * 8);
  const int fsw = (lane >> 1) & 7, fq = lane >> 4, fr = lane & 15;
  uint4 ax0, ax1, ax2, ax3, aw0, aw1, aw2, aw3, bx0, bx1, bx2, bx3, bw0, bw1, bw2, bw3;
#define G_LOAD(P, kt_) do { const u16* x_ = gx + (kt_) * 64; const u16* w_ = gw + (kt_) * 64; \
    P##x0 = *(const uint4*)(x_); P##x1 = *(const uint4*)(x_ + 32 * 1024); P##x2 = *(const uint4*)(x_ + 64 * 1024); P##x3 = *(const uint4*)(x_ + 96 * 1024); \
    P##w0 = *(const uint4*)(w_); P##w1 = *(const uint4*)(w_ + 32 * 1024); P##w2 = *(const uint4*)(w_ + 64 * 1024); P##w3 = *(const uint4*)(w_ + 96 * 1024); } while (0)
#define G_STORE(P, b_) do { u16* x_ = sX + (b_) * 128 * 64 + lo; u16* w_ = sW + (b_) * 128 * 64 + lo; \
    *(uint4*)(x_) = P##x0; *(uint4*)(x_ + 32 * 64) = P##x1; *(uint4*)(x_ + 64 * 64) = P##x2; *(uint4*)(x_ + 96 * 64) = P##x3; \
    *(uint4*)(w_) = P##w0; *(uint4*)(w_ + 32 * 64) = P##w1; *(uint4*)(w_ + 64 * 64) = P##w2; *(uint4*)(w_ + 96 * 64) = P##w3; } while (0)
#define G_COMPUTE(b_) do { const u16* cx = sX + (b_) * 128 * 64; const u16* cw = sW + (b_) * 128 * 64; \
    _Pragma("unroll") for (int ks = 0; ks < 2; ++ks) { bf16x8 a[4], b[4]; \
      _Pragma("unroll") for (int i = 0; i < 4; ++i) a[i] = *(const bf16x8*)(cw + (wn * 64 + i * 16 + fr) * 64 + (((ks * 4 + fq) ^ fsw) * 8)); \
      _Pragma("unroll") for (int j = 0; j < 4; ++j) b[j] = *(const bf16x8*)(cx + (wm * 64 + j * 16 + fr) * 64 + (((ks * 4 + fq) ^ fsw) * 8)); \
      _Pragma("unroll") for (int i = 0; i < 4; ++i) _Pragma("unroll") for (int j = 0; j < 4; ++j) \
        acc[i][j] = __builtin_amdgcn_mfma_f32_16x16x32_bf16(a[i], b[j], acc[i][j], 0, 0, 0); } } while (0)
  G_LOAD(a, 0);
  G_STORE(a, 0);
  G_LOAD(a, 1);
  G_LOAD(b, 2);
  __syncthreads();
#pragma unroll 1
  for (int kt = 0; kt < 12; kt += 2) {
    G_STORE(a, 1);
    G_LOAD(a, kt + 3);
    G_COMPUTE(0);
    __syncthreads();
    G_STORE(b, 0);
    G_LOAD(b, kt + 4);
    G_COMPUTE(1);
    __syncthreads();
  }
  G_STORE(a, 1);
  G_LOAD(a, 15);
  G_COMPUTE(0);
  __syncthreads();
  G_STORE(b, 0);
  G_COMPUTE(1);
  __syncthreads();
  G_STORE(a, 1);
  G_COMPUTE(0);
  __syncthreads();
  G_COMPUTE(1);
  __syncthreads();
  __builtin_amdgcn_sched_barrier(0);
#pragma unroll
  for (int j = 0; j < 4; ++j) {
    const int m = opq(m0 + wm * 64 + j * 16 + (lane & 15));
    float rowv = epi.row_begin(m);
#pragma unroll
    for (int i = 0; i < 4; ++i) {
      const int n = n0 + wn * 64 + i * 16 + (lane >> 4) * 4;
      epi(m, n, acc[i][j], rowv);
    }
    epi.row_end(m, (n0 >> 7) * 2 + wn, lane, rowv);
  }
}

struct EpiBF16 {
  u16* C; int ldc; int nmax;
  __device__ __forceinline__ float row_begin(int) const { return 0.f; }
  __device__ __forceinline__ void row_end(int, int, int, float) const {}
  __device__ __forceinline__ void operator()(int m, int n, f32x4 v, float&) const {
    if (n < nmax) {
      uint2 o; o.x = pack2(v[0], v[1]); o.y = pack2(v[2], v[3]);
      *(uint2*)(C + (size_t)m * ldc + n) = o;
    }
  }
};
struct EpiBF16Rstd {
  u16* C; int ldc; int nmax; const float* part;
  __device__ __forceinline__ float row_begin(int m) const {
    const float4* q = (const float4*)(part + (size_t)m * 16);
    const float4 a = q[0], b = q[1], c = q[2], d = q[3];
    const float s = ((a.x + a.y) + (a.z + a.w)) + ((b.x + b.y) + (b.z + b.w)) + ((c.x + c.y) + (c.z + c.w)) + ((d.x + d.y) + (d.z + d.w));
    return rsqrtf(s * (1.f / 1024.f) + 1e-6f);
  }
  __device__ __forceinline__ void row_end(int, int, int, float) const {}
  __device__ __forceinline__ void operator()(int m, int n, f32x4 v, float& r) const {
    if (n < nmax) {
      uint2 o; o.x = pack2(v[0] * r, v[1] * r); o.y = pack2(v[2] * r, v[3] * r);
      *(uint2*)(C + (size_t)m * ldc + n) = o;
    }
  }
};
struct EpiRes {
  const float* p0; const float* p1; float* h; u16* hb; float* part; const float* gn;
  __device__ __forceinline__ float row_begin(int) const { return 0.f; }
  __device__ __forceinline__ void row_end(int m, int slot, int lane, float ss) const {
    ss += __shfl_xor(ss, 16, 64);
    ss += __shfl_xor(ss, 32, 64);
    if ((lane >> 4) == 0) part[(size_t)m * 16 + slot] = ss;
  }
  __device__ __forceinline__ void operator()(int m, int n, f32x4 v, float& ss) const {
    const float* s = hsrc(p0, p1, m);
    float4 a = *(const float4*)(s + n);
    const float h0 = a.x + v[0], h1 = a.y + v[1], h2 = a.z + v[2], h3 = a.w + v[3];
    *(float4*)(h + (size_t)m * 1024 + n) = make_float4(h0, h1, h2, h3);
    const float4 gq = *(const float4*)(gn + n);
    uint2 o; o.x = pack2(h0 * gq.x, h1 * gq.y); o.y = pack2(h2 * gq.z, h3 * gq.w);
    *(uint2*)(hb + (size_t)m * 1024 + n) = o;
    ss += h0 * h0 + h1 * h1 + h2 * h2 + h3 * h3;
  }
};
struct EpiMemKV {
  float* outK; float* outV; u16* mkb; u16* mvt;
  __device__ __forceinline__ float row_begin(int) const { return 0.f; }
  __device__ __forceinline__ void row_end(int, int, int, float) const {}
  __device__ __forceinline__ void operator()(int m, int n, f32x4 v, float&) const {
    if (n < 1024) {
      *(float4*)(outK + (size_t)m * 1024 + n) = make_float4(v[0], v[1], v[2], v[3]);
      uint2 o; o.x = pack2(v[0], v[1]); o.y = pack2(v[2], v[3]);
      *(uint2*)(mkb + (size_t)m * 1024 + n) = o;
    } else {
      int nn = n - 1024;
      *(float4*)(outV + (size_t)m * 1024 + nn) = make_float4(v[0], v[1], v[2], v[3]);
      int b = m >> 8, mm = m & 255;
#pragma unroll
      for (int r = 0; r < 4; ++r) mvt[((size_t)b * 1024 + nn + r) * 256 + mm] = f2bf(v[r]);
    }
  }
};

__device__ void convert_tables(const Params& p, int ob, int on, int lbeg, int lend) {
  const int tid = TIDX;
  const float4* u4 = (const float4*)p.peer_u; const float4* v4 = (const float4*)p.peer_v;
  uint4* ub = (uint4*)(p.ws + W_UB); uint4* vb = (uint4*)(p.ws + W_VB);
  const size_t per_layer = 16384ull * 1024 / 16;
  const size_t n16 = per_layer * lend;
  for (size_t i = per_layer * lbeg + (size_t)ob * 256 + tid; i < n16; i += (size_t)on * 256) {
    uint32_t o[4];
#pragma unroll
    for (int w = 0; w < 4; ++w) {
      float4 a = ldnt4(u4 + 4 * i + w);
      int r = __builtin_amdgcn_cvt_pk_fp8_f32(a.x * 128.f, a.y * 128.f, 0, false);
      r = __builtin_amdgcn_cvt_pk_fp8_f32(a.z * 128.f, a.w * 128.f, r, true);
      o[w] = (uint32_t)r;
    }
    ub[i] = make_uint4(o[0], o[1], o[2], o[3]);
#pragma unroll
    for (int w = 0; w < 4; ++w) {
      float4 a = ldnt4(v4 + 4 * i + w);
      int r = __builtin_amdgcn_cvt_pk_fp8_f32(a.x * 64.f, a.y * 64.f, 0, false);
      r = __builtin_amdgcn_cvt_pk_fp8_f32(a.z * 64.f, a.w * 64.f, r, true);
      o[w] = (uint32_t)r;
    }
    vb[i] = make_uint4(o[0], o[1], o[2], o[3]);
  }
}
__device__ void phase0a(const Params& p, unsigned char* smem) {
  const int tid = TIDX, bid = blockIdx.x, nb = gridDim.x;
  const int lane = tid & 63, wave = tid >> 6;
  float* tile = (float*)smem;
  u16* WT = (u16*)(p.ws + W_WT);
  for (int it = bid; it < 2 * 2336; it += nb) {
    int l = it / 2336, r = it % 2336;
    int kt = r & 15, nt = r >> 4;
    const float* src; int N, drow, ntl;
    if (nt < 50) { src = p.w_in + (size_t)l * 1024 * PIN; N = PIN; drow = 0; ntl = nt; }
    else {
      int q = (nt - 50) >> 4; ntl = (nt - 50) & 15; N = 1024; drow = 3200 + q * 1024;

      const float* base = q == 0 ? p.w_out : q == 1 ? p.w_mq : q == 2 ? p.w_mo : q == 3 ? p.peer_wq : q == 4 ? p.w_mk : p.w_mv;
      src = base + (size_t)l * 1024 * 1024;
    }
    int k0 = kt * 64, n0 = ntl * 64;
#pragma unroll
    for (int i = 0; i < 4; ++i) {
      int rr = (tid >> 4) + 16 * i, c4 = (tid & 15) * 4;
      float4 v = make_float4(0.f, 0.f, 0.f, 0.f);
      if (n0 + c4 < N) v = *(const float4*)(src + (size_t)(k0 + rr) * N + n0 + c4);
      tile[rr * 65 + c4 + 0] = v.x; tile[rr * 65 + c4 + 1] = v.y; tile[rr * 65 + c4 + 2] = v.z; tile[rr * 65 + c4 + 3] = v.w;
    }
    __syncthreads();
    {
      int n = tid >> 2, ks = (tid & 3) * 16;
      uint32_t o[8];
#pragma unroll
      for (int j = 0; j < 8; ++j) o[j] = pack2(tile[(ks + 2 * j) * 65 + n], tile[(ks + 2 * j + 1) * 65 + n]);
      u16* d = WT + ((size_t)l * WTROWS + drow + n0 + n) * 1024 + k0 + ks;
      *(uint4*)d = make_uint4(o[0], o[1], o[2], o[3]);
      *(uint4*)(d + 8) = make_uint4(o[4], o[5], o[6], o[7]);
    }
    __syncthreads();
  }
  if (gridDim.x <= 256) convert_tables(p, bid, nb, 0, 2);
  {
    u16* keyb = (u16*)(p.ws + W_KEYB);
    for (int i = bid * 256 + tid; i < 2 * 8 * 2 * 128 * 64 / 4; i += nb * 256) {
      float4 a = ((const float4*)p.peer_keys)[i];
      *(uint2*)(keyb + (size_t)i * 4) = make_uint2(pack2(a.x, a.y), pack2(a.z, a.w));
    }
  }
  const int gw = bid * 4 + wave, nw = nb * 4;
  {
    u16* memn = (u16*)(p.ws + W_MEMN);
    for (int r = gw; r < 4096; r += nw) {
      int l = r >> 11, row = r & 2047;
      rms_row_bf16(p.mem_prompt + (size_t)row * 1024, p.mem_norm_g + l * 1024, memn + ((size_t)l * 2048 + row) * 1024, lane);
    }
  }
  {
    u16* nbuf = (u16*)(p.ws + W_NB);
    for (int t = gw; t < NTOK; t += nw)
      rms_row_bf16(hsrc(p.x_prompt, p.x_sample, t), p.norm_mix_g, nbuf + (size_t)t * 1024, lane);
  }
}

__device__ void phase_norm(const Params& p, const float* g) {
  const int lane = TIDX & 63, gw = blockIdx.x * 4 + (TIDX >> 6), nw = gridDim.x * 4;
  const float* h = (const float*)(p.ws + W_H);
  u16* nbuf = (u16*)(p.ws + W_NB);
  for (int t = gw; t < NTOK; t += nw) rms_row_bf16(h + (size_t)t * 1024, g, nbuf + (size_t)t * 1024, lane);
}

__device__ void phase_g1(const Params& p, int l, unsigned char* smem) {
  const u16* WT = (const u16*)(p.ws + W_WT) + (size_t)l * WTROWS * 1024;
  const u16* nbuf = (const u16*)(p.ws + W_NB);
  const int ntile = 136 * 25 + (l == 0 ? 512 : 0);
  for (int it = blockIdx.x; it < ntile; it += gridDim.x) {
    if (it < 3400) {
      const int xcd = it & 7, j = it >> 3;
      int mt = (j / 25) * 8 + xcd, ct = j % 25;
      EpiBF16 e{(u16*)(p.ws + W_PROJ), PIN, PIN};
      gemm_tile(nbuf, WT, mt * 128, ct * 128, (u16*)smem, e);
    } else {
      int r = it - 3400; int ll = r >> 8; r &= 255;
      int mt = r >> 4, ct = r & 15;
      const u16* WT2 = (const u16*)(p.ws + W_WT) + ((size_t)ll * WTROWS + 7296) * 1024;
      EpiMemKV e{p.out + O_MKP + (size_t)ll * 2048 * 1024, p.out + O_MVP + (size_t)ll * 2048 * 1024,
                 (u16*)(p.ws + W_MKB) + (size_t)ll * 2048 * 1024, (u16*)(p.ws + W_MVT) + (size_t)ll * 2048 * 1024};
      gemm_tile((const u16*)(p.ws + W_MEMN) + (size_t)ll * 2048 * 1024, WT2, mt * 128, ct * 128, (u16*)smem, e);
    }
  }
}
template <class Epi>
__device__ void phase_gemm1024(const u16* X, const u16* W, unsigned char* smem, const Epi& e) {
  for (int it = blockIdx.x; it < 136 * 8; it += gridDim.x) {
    const int xcd = it & 7, j = it >> 3;
    int mt = (j >> 3) * 8 + xcd, ct = j & 7;
    gemm_tile(X, W, mt * 128, ct * 128, (u16*)smem, e);
  }
}

__device__ __forceinline__ void unpack8(const uint4 u, float (&f)[8]) {
  f[0] = bflo(u.x); f[1] = bfhi(u.x); f[2] = bflo(u.y); f[3] = bfhi(u.y);
  f[4] = bflo(u.z); f[5] = bfhi(u.z); f[6] = bflo(u.w); f[7] = bfhi(u.w);
}
__device__ __forceinline__ uint4 pack8u(const float (&f)[8]) {
  return make_uint4(pack2(f[0], f[1]), pack2(f[2], f[3]), pack2(f[4], f[5]), pack2(f[6], f[7]));
}
__device__ __forceinline__ void conv_finish(const Params& p, int l, int t, int ps, int lane, bool smp, int b, int tp, int T, const float (&xr)[4][8],
                                            const float* cw, u16* qkv, float* bg, float (&yq)[8]) {
  const int c = ps * 512 + lane * 8;
  float y[8];
#pragma unroll
  for (int i = 0; i < 8; ++i) y[i] = 0.f;
#pragma unroll
  for (int j = 0; j < 4; ++j) {
    float4 w0 = *(const float4*)(cw + j * 1536 + c), w1 = *(const float4*)(cw + j * 1536 + c + 4);
    y[0] += w0.x * xr[j][0]; y[1] += w0.y * xr[j][1]; y[2] += w0.z * xr[j][2]; y[3] += w0.w * xr[j][3];
    y[4] += w1.x * xr[j][4]; y[5] += w1.y * xr[j][5]; y[6] += w1.z * xr[j][6]; y[7] += w1.w * xr[j][7];
  }
#pragma unroll
  for (int i = 0; i < 8; ++i) y[i] = silu_f(y[i]);
  if (ps < 2) {
    float ss = 0.f;
#pragma unroll
    for (int i = 0; i < 8; ++i) ss += y[i] * y[i];
    ss = row_sum16(ss);
    float r = rsqrtf(ss + 1e-6f);
    if (ps == 0) r *= 0.08838834764831845f;
#pragma unroll
    for (int i = 0; i < 8; ++i) y[i] *= r;
  }
  const uint4 ypk = pack8u(y);
  *(uint4*)(qkv + (size_t)t * 1536 + c) = ypk;
  if (ps == 0) unpack8(ypk, yq);
  if (ps == 1) {
    float yk[8];
    unpack8(ypk, yk);
    float d = 0.f;
#pragma unroll
    for (int i = 0; i < 8; ++i) d += yq[i] * yk[i];
    d = row_sum16(d);
    if ((lane & 15) == 0) bg[(size_t)t * 12 + 8 + (lane >> 4)] = d;
  }
  if (tp >= T - 3) {
    float* o = (smp ? p.out + O_SCS + ((size_t)(l * 128 + b) * 3 + (tp - (T - 3))) * 1536
                    : p.out + O_SCP + ((size_t)(l * 8 + b) * 3 + (tp - (T - 3))) * 1536) + c;
    *(float4*)o = make_float4(xr[3][0], xr[3][1], xr[3][2], xr[3][3]);
    *(float4*)(o + 4) = make_float4(xr[3][4], xr[3][5], xr[3][6], xr[3][7]);
  }
}
__device__ void phase_prep(const Params& p, int l, unsigned char* smem) {
  const int lane = TIDX & 63, gw = blockIdx.x * 4 + (TIDX >> 6), nw = gridDim.x * 4;
  const u16* proj = (const u16*)(p.ws + W_PROJ);
  u16* qkv = (u16*)(p.ws + W_QKV);
  float* bg = (float*)(p.ws + W_BG);
  u16* su = (u16*)(p.ws + W_SU);
  u16* vvb = (u16*)(p.ws + W_VV);
  float* cwl = (float*)smem;
  float* lgl = cwl + 4 * 1536;
  float* lbl = lgl + 512;
  {
    const int tid = TIDX;
    const float4* s4 = (const float4*)(p.conv_w + (size_t)l * 4 * 1536);
    for (int i = tid; i < 1536; i += 256) ((float4*)cwl)[i] = s4[i];
    if (tid < 128) ((float4*)lgl)[tid] = ((const float4*)(p.sg_ln_g + (size_t)l * 512))[tid];
    else ((float4*)lbl)[tid - 128] = ((const float4*)(p.sg_ln_b + (size_t)l * 512))[tid - 128];
    __syncthreads();
  }
  const float* cw = cwl;
  for (int t = gw; t < NTOK; t += nw) {
    const bool smp = t >= NPR;
    int b, tp, T;
    if (!smp) { b = t >> 11; tp = t & 2047; T = 2048; } else { b = (t - NPR) >> 3; tp = (t - NPR) & 7; T = 8; }
    const u16* pr = proj + (size_t)t * PIN;
    const float* sc = p.state_conv + ((size_t)(l * 128 + (smp ? b : 0)) * 3) * 1536;
    float yq[8];
    const uint4 ugu = *(const uint4*)(pr + 2056 + lane * 8);
    const uint4 ugv = *(const uint4*)(pr + 2568 + lane * 8);
    if (tp >= 3) {
      uint4 rr[3][4];
#pragma unroll
      for (int ps = 0; ps < 3; ++ps)
#pragma unroll
        for (int j = 0; j < 4; ++j) rr[ps][j] = *(const uint4*)(pr - (size_t)(3 - j) * PIN + ps * 512 + lane * 8);
#pragma unroll
      for (int ps = 0; ps < 3; ++ps) {
        float xr[4][8];
#pragma unroll
        for (int j = 0; j < 4; ++j) unpack8(rr[ps][j], xr[j]);
        conv_finish(p, l, t, ps, lane, smp, b, tp, T, xr, cw, qkv, bg, yq);
      }
    } else {
#pragma unroll
      for (int ps = 0; ps < 3; ++ps) {
        const int c = ps * 512 + lane * 8;
        float xr[4][8];
#pragma unroll
        for (int j = 0; j < 4; ++j) {
          const int back = 3 - j;
          if (tp >= back) {
            unpack8(*(const uint4*)(pr - (size_t)back * PIN + c), xr[j]);
          } else if (smp) {
            const float* s_ = sc + (size_t)(3 + tp - back) * 1536 + c;
            float4 f0 = *(const float4*)s_, f1 = *(const float4*)(s_ + 4);
            xr[j][0] = f0.x; xr[j][1] = f0.y; xr[j][2] = f0.z; xr[j][3] = f0.w; xr[j][4] = f1.x; xr[j][5] = f1.y; xr[j][6] = f1.z; xr[j][7] = f1.w;
          } else {
#pragma unroll
            for (int i = 0; i < 8; ++i) xr[j][i] = 0.f;
          }
        }
        conv_finish(p, l, t, ps, lane, smp, b, tp, T, xr, cw, qkv, bg, yq);
      }
    }
    if (lane < 4) {
      float ba = bf2f(pr[2048 + lane]), aa = bf2f(pr[2052 + lane]);
      float beta = 1.f / (1.f + __expf(-ba));
      float xx = aa + p.dt_bias[l * 4 + lane];
      float sp = xx > 20.f ? xx : log1pf(__expf(xx));
      float g = -__expf(p.a_log[l * 4 + lane]) * sp;
      bg[(size_t)t * 12 + lane] = beta;
      bg[(size_t)t * 12 + 4 + lane] = __expf(g);
    }
    {
      const int c = lane * 8;
      float u[8], gv[8];
      unpack8(ugu, u);
      unpack8(ugv, gv);
#pragma unroll
      for (int i = 0; i < 8; ++i) { u[i] = gelu_t(u[i]); gv[i] = gelu_t(gv[i]); }
      *(uint4*)(su + (size_t)t * 512 + c) = pack8u(u);
      float s1 = 0.f;
#pragma unroll
      for (int i = 0; i < 8; ++i) s1 += gv[i];
      const float mu = row_sum16(s1) * (1.f / 128.f);
      float s2 = 0.f;
#pragma unroll
      for (int i = 0; i < 8; ++i) { gv[i] -= mu; s2 += gv[i] * gv[i]; }
      const float r = rsqrtf(row_sum16(s2) * (1.f / 128.f) + 1e-6f);
      const float* lg = lgl + c;
      const float* lb = lbl + c;
      float4 g0 = *(const float4*)lg, g1 = *(const float4*)(lg + 4), b0 = *(const float4*)lb, b1 = *(const float4*)(lb + 4);
      float o[8];
      o[0] = gv[0] * r * g0.x + b0.x; o[1] = gv[1] * r * g0.y + b0.y; o[2] = gv[2] * r * g0.z + b0.z; o[3] = gv[3] * r * g0.w + b0.w;
      o[4] = gv[4] * r * g1.x + b1.x; o[5] = gv[5] * r * g1.y + b1.y; o[6] = gv[6] * r * g1.z + b1.z; o[7] = gv[7] * r * g1.w + b1.w;
      *(uint4*)(vvb + (size_t)t * 512 + c) = pack8u(o);
      if (smp) {
        float* d = p.out + O_VRS + ((size_t)(l * 128 + b) * 8 + tp) * 512 + c;
        *(float4*)d = make_float4(o[0], o[1], o[2], o[3]);
        *(float4*)(d + 4) = make_float4(o[4], o[5], o[6], o[7]);
      }
    }
  }
}

typedef __attribute__((ext_vector_type(2))) float v2f;
__device__ __forceinline__ void delta_prompt_wave(const Params& p, int l, int wi, int lane, unsigned char* smem) {
  const int b = wi >> 7, h = (wi >> 5) & 3, sl = wi & 31;
  const int c = lane >> 4, rg = lane & 15, e0 = sl * 4, d0 = rg * 8;
  const u16* qkv = (const u16*)(p.ws + W_QKV);
  const float* bg = (const float*)(p.ws + W_BG);
  float* ob = (float*)(p.ws + W_O);
  constexpr int WB = 8192 + 128 + 128;
  v2f S0 = {0.f, 0.f}, S1 = {0.f, 0.f}, S2 = {0.f, 0.f}, S3 = {0.f, 0.f};
  const size_t tbase = (size_t)b * 2048;
  uint4 r0, r1, r2, r3; uint2 rv = make_uint2(0, 0); float rba = 0.f;
  const int p0 = lane & 31, tk0 = lane >> 5;
  const size_t koff = (size_t)tk0 * 1536 + (p0 < 16 ? 512 + h * 128 + p0 * 8 : h * 128 + (p0 - 16) * 8);
  const int loff = (tk0 * 256 + p0 * 8) * 4;
#define DQ_LOAD(ci_) do { const size_t tb_ = tbase + (size_t)(ci_) * 8; const u16* q0_ = qkv + tb_ * 1536 + koff; \
    r0 = *(const uint4*)(q0_); r1 = *(const uint4*)(q0_ + 2 * 1536); r2 = *(const uint4*)(q0_ + 4 * 1536); r3 = *(const uint4*)(q0_ + 6 * 1536); \
    if (lane < 8) rv = *(const uint2*)(qkv + (tb_ + lane) * 1536 + 1024 + h * 128 + e0); \
    else if (lane < 40) rba = (((lane - 8) & 3) < 3) ? bg[(tb_ + ((lane - 8) >> 2)) * 12 + ((lane - 8) & 3) * 4 + h] : 0.f; } while (0)
#define DQ_ST1(dst_, r_) do { *(float4*)(dst_) = make_float4(bflo(r_.x), bfhi(r_.x), bflo(r_.y), bfhi(r_.y)); \
    *(float4*)((dst_) + 16) = make_float4(bflo(r_.z), bfhi(r_.z), bflo(r_.w), bfhi(r_.w)); } while (0)
#define DQ_STORE(bi_) do { unsigned char* b_ = wbase + (bi_) * WB; \
    DQ_ST1(b_ + loff, r0); DQ_ST1(b_ + loff + 2048, r1); DQ_ST1(b_ + loff + 4096, r2); DQ_ST1(b_ + loff + 6144, r3); \
    if (lane < 8) *(float4*)(b_ + 8192 + lane * 16) = make_float4(bflo(rv.x), bfhi(rv.x), bflo(rv.y), bfhi(rv.y)); \
    else if (lane < 40) *(float*)(b_ + 8320 + (lane - 8) * 4) = rba; } while (0)
  unsigned char* wbase = smem + (wi & 3) * (2 * WB);
  DQ_LOAD(0);
  DQ_STORE(0);
  DQ_LOAD(1);
  for (int ci = 0; ci < 256; ++ci) {
    if (ci + 1 < 256) DQ_STORE((ci + 1) & 1);
    if (ci + 2 < 256) DQ_LOAD(ci + 2);
    const unsigned char* base = wbase + (ci & 1) * WB;
    float* o_ = ob + (tbase + (size_t)ci * 8) * 512 + h * 128 + e0 + c;
    float4 ka = *(const float4*)(base + d0 * 4), kb = *(const float4*)(base + d0 * 4 + 16);
    float4 qa = *(const float4*)(base + 512 + d0 * 4), qb = *(const float4*)(base + 512 + d0 * 4 + 16);
    float v = *(const float*)(base + 8192 + c * 4);
    float4 ba = *(const float4*)(base + 8320);
    float ov[8];
#pragma unroll
    for (int s = 0; s < 8; ++s) {
      const v2f k0 = {ka.x, ka.y}, k1 = {ka.z, ka.w}, k2 = {kb.x, kb.y}, k3 = {kb.z, kb.w};
      const v2f q0 = {qa.x, qa.y}, q1 = {qa.z, qa.w}, q2 = {qb.x, qb.y}, q3 = {qb.z, qb.w};
      const float beta = ba.x, a = ba.y, kq = ba.z;
      const float vcur = v;
      if (s < 7) {
        ka = *(const float4*)(base + (s + 1) * 1024 + d0 * 4); kb = *(const float4*)(base + (s + 1) * 1024 + d0 * 4 + 16);
        qa = *(const float4*)(base + (s + 1) * 1024 + 512 + d0 * 4); qb = *(const float4*)(base + (s + 1) * 1024 + 512 + d0 * 4 + 16);
        v = *(const float*)(base + 8192 + ((s + 1) * 4 + c) * 4);
        ba = *(const float4*)(base + 8320 + (s + 1) * 16);
      }
      const v2f pk2 = (S0 * k0 + S1 * k1) + (S2 * k2 + S3 * k3);
      const v2f pq2 = (S0 * q0 + S1 * q1) + (S2 * q2 + S3 * q3);
      float pk = pk2[0] + pk2[1], pq = pq2[0] + pq2[1];
      const v2f a2 = {a, a};
      const v2f aS0 = a2 * S0, aS1 = a2 * S1, aS2 = a2 * S2, aS3 = a2 * S3;
      pk = row_sum16(pk); pq = row_sum16(pq);
      const float vn = beta * (vcur - a * pk);
      const v2f vn2 = {vn, vn};
      S0 = aS0 + k0 * vn2; S1 = aS1 + k1 * vn2; S2 = aS2 + k2 * vn2; S3 = aS3 + k3 * vn2;
      ov[s] = a * pq + vn * kq;
    }
    if (rg == 0) {
#pragma unroll
      for (int s = 0; s < 8; ++s) o_[s * 512] = ov[s];
    }
  }
  float* so = p.out + O_SDP + ((size_t)((l * 8 + b) * 4 + h) * 128) * 128 + (size_t)d0 * 128 + e0 + c;
  so[0] = S0[0]; so[128] = S0[1]; so[256] = S1[0]; so[384] = S1[1]; so[512] = S2[0]; so[640] = S2[1]; so[768] = S3[0]; so[896] = S3[1];
}

__device__ void delta_sample_block(const Params& p, int l, int item, unsigned char* smem) {
  const int tid = TIDX, lane = tid & 63, wave = tid >> 6;
  float* skq = (float*)smem;
  float* skk = skq + 8 * 256;
  const u16* qkv = (const u16*)(p.ws + W_QKV);
  const float* bg = (const float*)(p.ws + W_BG);
  float* ob = (float*)(p.ws + W_O);
  const int b = item >> 2, h = item & 3;
  for (int i = tid; i < 8 * 256; i += 256) {
    int t = i >> 8, d = i & 255;
    size_t tok = NPR + (size_t)b * 8 + t;
    float v = (d < 128) ? bf2f(qkv[tok * 1536 + 512 + h * 128 + d]) : bf2f(qkv[tok * 1536 + h * 128 + (d - 128)]);
    skq[i] = v;
  }
  __syncthreads();
  if (tid < 8) {
    const float* r = skq + tid * 256;
    float s = 0.f;
    for (int d = 0; d < 128; ++d) s += r[d] * r[128 + d];
    skk[tid] = s;
  }
  __syncthreads();
  {
    const int e = wave * 32 + (lane & 31);
    const int rh = lane >> 5;
    const float* s0 = p.state_delta + ((size_t)((l * 128 + b) * 4 + h) * 128 + rh * 64) * 128 + e;
    float S[64];
#pragma unroll
    for (int d = 0; d < 64; ++d) S[d] = __builtin_nontemporal_load(s0 + (size_t)d * 128);
    for (int t = 0; t < 8; ++t) {
      const size_t tok = NPR + (size_t)b * 8 + t;
      const float* kr = skq + t * 256 + rh * 64;
      float pk = 0.f, pq = 0.f;
#pragma unroll
      for (int d4 = 0; d4 < 16; ++d4) {
        float4 kk = *(const float4*)(kr + d4 * 4);
        float4 qq = *(const float4*)(kr + 128 + d4 * 4);
        pk += S[d4 * 4 + 0] * kk.x + S[d4 * 4 + 1] * kk.y + S[d4 * 4 + 2] * kk.z + S[d4 * 4 + 3] * kk.w;
        pq += S[d4 * 4 + 0] * qq.x + S[d4 * 4 + 1] * qq.y + S[d4 * 4 + 2] * qq.z + S[d4 * 4 + 3] * qq.w;
      }
      pk += __shfl_xor(pk, 32, 64);
      pq += __shfl_xor(pq, 32, 64);
      const float a = bg[tok * 12 + 4 + h], beta = bg[tok * 12 + h];
      const float v = bf2f(qkv[tok * 1536 + 1024 + h * 128 + e]);
      const float vn = beta * (v - a * pk);
      const float o = a * pq + vn * skk[t];
#pragma unroll
      for (int d4 = 0; d4 < 16; ++d4) {
        float4 kk = *(const float4*)(kr + d4 * 4);
        S[d4 * 4 + 0] = a * S[d4 * 4 + 0] + kk.x * vn;
        S[d4 * 4 + 1] = a * S[d4 * 4 + 1] + kk.y * vn;
        S[d4 * 4 + 2] = a * S[d4 * 4 + 2] + kk.z * vn;
        S[d4 * 4 + 3] = a * S[d4 * 4 + 3] + kk.w * vn;
      }
      if (lane < 32) ob[tok * 512 + h * 128 + e] = o;
    }
    float* so = p.out + O_SDS + ((size_t)((l * 128 + b) * 4 + h) * 128 + rh * 64) * 128 + e;
#pragma unroll
    for (int d = 0; d < 64; ++d) so[(size_t)d * 128] = S[d];
  }
  __syncthreads();
}

__device__ void sgu_prompt_block(const Params& p, int l, int item, unsigned char* smem) {
  const int tid = TIDX, lane = tid & 63, wave = tid >> 6;
  const int grp = item & 3, ch = (item >> 2) & 15, b = item >> 6;
  const int tok0 = b * 2048 + ch * 128;
  u16* sWg = (u16*)smem;
  u16* sVT = sWg + 128 * 136;
  const float* wg = p.sg_w + ((size_t)(l * 4 + grp) * 128) * 128;
  const u16* vvb = (const u16*)(p.ws + W_VV);
  const u16* su = (const u16*)(p.ws + W_SU);
  u16* cat = (u16*)(p.ws + W_CAT);
#pragma unroll
  for (int i = 0; i < 16; ++i) {
    int idx = tid + 256 * i;
    int t = idx >> 5, s4 = (idx & 31) * 4;
    float4 w = *(const float4*)(wg + t * 128 + s4);
    if (s4 + 0 > t) w.x = 0.f;
    if (s4 + 1 > t) w.y = 0.f;
    if (s4 + 2 > t) w.z = 0.f;
    if (s4 + 3 > t) w.w = 0.f;
    uint2 o; o.x = pack2(w.x, w.y); o.y = pack2(w.z, w.w);
    *(uint2*)(sWg + t * 136 + s4) = o;
  }
#pragma unroll
  for (int i = 0; i < 8; ++i) {
    int idx = tid + 256 * i;
    int s = idx >> 4, c8 = (idx & 15) * 8;
    uint4 v = *(const uint4*)(vvb + (size_t)(tok0 + s) * 512 + grp * 128 + c8);
    u16 e[8];
    e[0] = v.x & 0xffff; e[1] = v.x >> 16; e[2] = v.y & 0xffff; e[3] = v.y >> 16;
    e[4] = v.z & 0xffff; e[5] = v.z >> 16; e[6] = v.w & 0xffff; e[7] = v.w >> 16;
#pragma unroll
    for (int j = 0; j < 8; ++j) sVT[(c8 + j) * 136 + s] = e[j];
  }
  __syncthreads();
  const int wm = wave & 1, wn = wave >> 1;
  f32x4 acc[4][4];
#pragma unroll
  for (int i = 0; i < 4; ++i)
#pragma unroll
    for (int j = 0; j < 4; ++j) acc[i][j] = (f32x4){0.f, 0.f, 0.f, 0.f};
#pragma unroll
  for (int ks = 0; ks < 4; ++ks) {
    bf16x8 a[4], bb[4];
#pragma unroll
    for (int i = 0; i < 4; ++i) a[i] = *(const bf16x8*)(sVT + (wm * 64 + i * 16 + (lane & 15)) * 136 + ks * 32 + (lane >> 4) * 8);
#pragma unroll
    for (int j = 0; j < 4; ++j) bb[j] = *(const bf16x8*)(sWg + (wn * 64 + j * 16 + (lane & 15)) * 136 + ks * 32 + (lane >> 4) * 8);
#pragma unroll
    for (int i = 0; i < 4; ++i)
#pragma unroll
      for (int j = 0; j < 4; ++j) acc[i][j] = __builtin_amdgcn_mfma_f32_16x16x32_bf16(a[i], bb[j], acc[i][j], 0, 0, 0);
  }
#pragma unroll
  for (int i = 0; i < 4; ++i)
#pragma unroll
    for (int j = 0; j < 4; ++j) {
      int c = wm * 64 + i * 16 + (lane >> 4) * 4;
      int t = wn * 64 + j * 16 + (lane & 15);
      float bias = p.sg_b[(l * 4 + grp) * 128 + t];
      uint2 uu = *(const uint2*)(su + (size_t)(tok0 + t) * 512 + grp * 128 + c);
      uint2 o;
      o.x = pack2((acc[i][j][0] + bias) * bflo(uu.x), (acc[i][j][1] + bias) * bfhi(uu.x));
      o.y = pack2((acc[i][j][2] + bias) * bflo(uu.y), (acc[i][j][3] + bias) * bfhi(uu.y));
      *(uint2*)(cat + (size_t)(tok0 + t) * 1024 + 512 + grp * 128 + c) = o;
    }
  __syncthreads();
}

__device__ void sgu_sample_block(const Params& p, int l, int item) {
  const int tid = TIDX;
  const int t = NPR + item, tp = item & 7;
  const int c = 2 * tid, grp = c >> 7;
  const u16* vvb = (const u16*)(p.ws + W_VV);
  const u16* su = (const u16*)(p.ws + W_SU);
  u16* cat = (u16*)(p.ws + W_CAT);
  const float* wr = p.sg_w + ((size_t)(l * 4 + grp) * 128 + tp) * 128;
  float a0 = 0.f, a1 = 0.f;
  for (int s = 0; s <= tp; ++s) {
    uint32_t u = *(const uint32_t*)(vvb + (size_t)(t - tp + s) * 512 + c);
    float w = wr[s];
    a0 += w * bflo(u); a1 += w * bfhi(u);
  }
  float bias = p.sg_b[(l * 4 + grp) * 128 + tp];
  uint32_t uu = *(const uint32_t*)(su + (size_t)t * 512 + c);
  *(uint32_t*)(cat + (size_t)t * 1024 + 512 + c) = pack2((a0 + bias) * bflo(uu), (a1 + bias) * bfhi(uu));
}

__device__ __forceinline__ int first_item(int lo) {
  const int G = gridDim.x;
  int r = ((int)blockIdx.x - lo) % G;
  if (r < 0) r += G;
  return lo + r;
}
__device__ void phase_mix(const Params& p, int l, unsigned char* smem) {
  const int lane = TIDX & 63, wave = TIDX >> 6;
  const int G = gridDim.x, bid = blockIdx.x;
  if (G > 256) {
    if (bid < 256) {
      delta_prompt_wave(p, l, bid * 4 + wave, lane, smem);
    } else {
      const int ob = bid - 256, on = G - 256;
      for (int it = ob; it < 512; it += on) delta_sample_block(p, l, it, smem);
      for (int it = ob; it < 512; it += on) sgu_prompt_block(p, l, it, smem);
      for (int it = ob; it < 1024; it += on) sgu_sample_block(p, l, it);
      convert_tables(p, ob, on, l, l + 1);
    }
  } else {
    for (int it = first_item(0); it < 256; it += G) { delta_prompt_wave(p, l, it * 4 + wave, lane, smem); __syncthreads(); }
    for (int it = first_item(256); it < 768; it += G) delta_sample_block(p, l, it - 256, smem);
    for (int it = first_item(768); it < 1280; it += G) sgu_prompt_block(p, l, it - 768, smem);
    for (int it = first_item(1280); it < 2304; it += G) sgu_sample_block(p, l, it - 1280);
  }
}

__device__ void phase_onorm(const Params& p, int l) {
  const int lane = TIDX & 63, gw = blockIdx.x * 4 + (TIDX >> 6), nw = gridDim.x * 4;
  const float* ob = (const float*)(p.ws + W_O);
  const u16* proj = (const u16*)(p.ws + W_PROJ);
  u16* cat = (u16*)(p.ws + W_CAT);
  for (int t = gw; t < NTOK; t += nw) {
#pragma unroll
    for (int h = 0; h < 4; ++h) {
      const int c = h * 128 + 2 * lane;
      float2 o = *(const float2*)(ob + (size_t)t * 512 + c);
      float ss = wave_sum(o.x * o.x + o.y * o.y);
      float r = rsqrtf(ss * (1.f / 128.f) + 1e-6f);
      float2 g = *(const float2*)(p.o_norm_g + l * 128 + 2 * lane);
      uint32_t z = *(const uint32_t*)(proj + (size_t)t * PIN + 1536 + c);
      *(uint32_t*)(cat + (size_t)t * 1024 + c) = pack2(o.x * r * g.x * silu_f(bflo(z)), o.y * r * g.y * silu_f(bfhi(z)));
    }
  }
}

__device__ void attn_prompt_block(const Params& p, int l, int item, unsigned char* smem) {
  const int tid = TIDX, lane = tid & 63, wave = tid >> 6;
  const int qt = item & 31, hd = (item >> 5) & 3, b = item >> 7;
  const int g = lane >> 4, li = lane & 15;
  constexpr int RS = 264;
  u16* bufs = (u16*)smem;
  const u16* qm = (const u16*)(p.ws + W_QM);
  const u16* mkb = (const u16*)(p.ws + W_MKB) + ((size_t)(l * 8 + b) * 256) * 1024 + hd * 256;
  const u16* mvt = (const u16*)(p.ws + W_MVT) + ((size_t)(l * 8 + b) * 1024 + hd * 256) * 256;
  u16* att = (u16*)(p.ws + W_ATT);
  const size_t tq = (size_t)b * 2048 + qt * 64 + wave * 16 + li;
  const int prow = tid >> 5, pcol = (tid & 31) * 8;
  uint4 c0, c1, c2, c3, c4, c5, c6, c7;
#define AP_LOAD(ch_) do { const u16* s_ = ((ch_) < 4) ? mkb + (size_t)((ch_) * 64 + prow) * 1024 + pcol : mvt + (size_t)(((ch_) - 4) * 64 + prow) * 256 + pcol; \
    const size_t rs_ = ((ch_) < 4) ? 8 * 1024 : 8 * 256; \
    c0 = *(const uint4*)(s_); c1 = *(const uint4*)(s_ + rs_); c2 = *(const uint4*)(s_ + 2 * rs_); c3 = *(const uint4*)(s_ + 3 * rs_); \
    c4 = *(const uint4*)(s_ + 4 * rs_); c5 = *(const uint4*)(s_ + 5 * rs_); c6 = *(const uint4*)(s_ + 6 * rs_); c7 = *(const uint4*)(s_ + 7 * rs_); } while (0)
#define AP_STORE(bi_) do { u16* d_ = bufs + (bi_) * 64 * RS + prow * RS + pcol; \
    *(uint4*)(d_) = c0; *(uint4*)(d_ + 8 * RS) = c1; *(uint4*)(d_ + 16 * RS) = c2; *(uint4*)(d_ + 24 * RS) = c3; \
    *(uint4*)(d_ + 32 * RS) = c4; *(uint4*)(d_ + 40 * RS) = c5; *(uint4*)(d_ + 48 * RS) = c6; *(uint4*)(d_ + 56 * RS) = c7; } while (0)
  AP_LOAD(0);
  bf16x8 qf[8];
#pragma unroll
  for (int ks = 0; ks < 8; ++ks) qf[ks] = *(const bf16x8*)(qm + tq * 1024 + hd * 256 + ks * 32 + g * 8);
  AP_STORE(0);
  AP_LOAD(1);
  __syncthreads();
  f32x4 st[16];
#pragma unroll
  for (int ch = 0; ch < 4; ++ch) {
    AP_STORE((ch + 1) & 1);
    AP_LOAD(ch + 2);
    const u16* cb = bufs + (ch & 1) * 64 * RS;
#pragma unroll
    for (int mt = 0; mt < 4; ++mt) {
      f32x4 acc = (f32x4){0.f, 0.f, 0.f, 0.f};
#pragma unroll
      for (int ks = 0; ks < 8; ++ks) {
        bf16x8 kf = *(const bf16x8*)(cb + (mt * 16 + li) * RS + ks * 32 + g * 8);
        acc = __builtin_amdgcn_mfma_f32_16x16x32_bf16(kf, qf[ks], acc, 0, 0, 0);
      }
      st[ch * 4 + mt] = acc;
    }
    __syncthreads();
  }
  float mx = -1e30f;
#pragma unroll
  for (int mt = 0; mt < 16; ++mt)
#pragma unroll
    for (int r = 0; r < 4; ++r) mx = fmaxf(mx, st[mt][r]);
  mx = fmaxf(mx, __shfl_xor(mx, 16, 64));
  mx = fmaxf(mx, __shfl_xor(mx, 32, 64));
  float sum = 0.f;
#pragma unroll
  for (int mt = 0; mt < 16; ++mt)
#pragma unroll
    for (int r = 0; r < 4; ++r) { float e = __expf((st[mt][r] - mx) * 0.0625f); st[mt][r] = e; sum += e; }
  sum += __shfl_xor(sum, 16, 64);
  sum += __shfl_xor(sum, 32, 64);
  const float inv = 1.f / sum;
  bf16x8 pf[8];
#pragma unroll
  for (int k2 = 0; k2 < 8; ++k2) {
    union { uint32_t u[4]; bf16x8 v; } r;
    r.u[0] = pack2(st[2 * k2][0], st[2 * k2][1]); r.u[1] = pack2(st[2 * k2][2], st[2 * k2][3]);
    r.u[2] = pack2(st[2 * k2 + 1][0], st[2 * k2 + 1][1]); r.u[3] = pack2(st[2 * k2 + 1][2], st[2 * k2 + 1][3]);
    pf[k2] = r.v;
  }
#pragma unroll
  for (int ch = 4; ch < 8; ++ch) {
    if (ch + 1 < 8) AP_STORE((ch + 1) & 1);
    if (ch + 2 < 8) AP_LOAD(ch + 2);
    const u16* cb = bufs + (ch & 1) * 64 * RS;
#pragma unroll
    for (int dtl = 0; dtl < 4; ++dtl) {
      f32x4 acc = (f32x4){0.f, 0.f, 0.f, 0.f};
      const u16* vr = cb + (dtl * 16 + li) * RS;
#pragma unroll
      for (int k2 = 0; k2 < 8; ++k2) {
        uint2 lo = *(const uint2*)(vr + k2 * 32 + 4 * g);
        uint2 hi = *(const uint2*)(vr + k2 * 32 + 16 + 4 * g);
        union { uint32_t u[4]; bf16x8 v; } r;
        r.u[0] = lo.x; r.u[1] = lo.y; r.u[2] = hi.x; r.u[3] = hi.y;
        acc = __builtin_amdgcn_mfma_f32_16x16x32_bf16(r.v, pf[k2], acc, 0, 0, 0);
      }
      uint2 o; o.x = pack2(acc[0] * inv, acc[1] * inv); o.y = pack2(acc[2] * inv, acc[3] * inv);
      *(uint2*)(att + tq * 1024 + hd * 256 + ((ch - 4) * 4 + dtl) * 16 + 4 * g) = o;
    }
    __syncthreads();
  }
}

__device__ void attn_sample_block(const Params& p, int l, int item, unsigned char* smem) {
  const int tid = TIDX, lane = tid & 63, wave = tid >> 6;
  const int hd = item & 3, b = item >> 2;
  const int g = lane >> 4, li = lane & 15;
  float* pl = (float*)smem;
  float* op = pl + 4 * 64 * 8;
  float* ml = op + 4 * 8 * 256;
  const u16* qm = (const u16*)(p.ws + W_QM);
  u16* att = (u16*)(p.ws + W_ATT);
  const size_t t0 = NPR + (size_t)b * 8;
  const float* kb = p.cache_mem_k + ((size_t)(l * 128 + b) * 256) * 1024 + hd * 256;
  const float* vb = p.cache_mem_v + ((size_t)(l * 128 + b) * 256) * 1024 + hd * 256;
  bf16x8 qf[8];
#pragma unroll
  for (int ks = 0; ks < 8; ++ks) {
    bf16x8 z = {0, 0, 0, 0, 0, 0, 0, 0};
    qf[ks] = (li < 8) ? *(const bf16x8*)(qm + (t0 + li) * 1024 + hd * 256 + ks * 32 + g * 8) : z;
  }
  f32x4 st[4];
#pragma unroll
  for (int mt = 0; mt < 4; ++mt) {
    const float* kr = kb + (size_t)(wave * 64 + mt * 16 + li) * 1024;
    f32x4 acc = (f32x4){0.f, 0.f, 0.f, 0.f};
#pragma unroll
    for (int ks = 0; ks < 8; ++ks) {
      float4 f0 = ldnt4((const float4*)(kr + ks * 32 + g * 8));
      float4 f1 = ldnt4((const float4*)(kr + ks * 32 + g * 8 + 4));
      acc = __builtin_amdgcn_mfma_f32_16x16x32_bf16(pack8(f0, f1), qf[ks], acc, 0, 0, 0);
    }
    st[mt] = acc;
  }
  float mx = -1e30f;
#pragma unroll
  for (int mt = 0; mt < 4; ++mt)
#pragma unroll
    for (int r = 0; r < 4; ++r) mx = fmaxf(mx, st[mt][r]);
  mx = fmaxf(mx, __shfl_xor(mx, 16, 64));
  mx = fmaxf(mx, __shfl_xor(mx, 32, 64));
  float sum = 0.f;
#pragma unroll
  for (int mt = 0; mt < 4; ++mt)
#pragma unroll
    for (int r = 0; r < 4; ++r) {
      float e = __expf((st[mt][r] - mx) * 0.0625f);
      sum += e;
      if (li < 8) pl[(wave * 64 + mt * 16 + 4 * g + r) * 8 + li] = e;
    }
  sum += __shfl_xor(sum, 16, 64);
  sum += __shfl_xor(sum, 32, 64);
  if (lane < 8) { ml[(wave * 8 + lane) * 2] = mx; ml[(wave * 8 + lane) * 2 + 1] = sum; }
  __syncthreads();
  {
    float4 acc[8];
#pragma unroll
    for (int q = 0; q < 8; ++q) acc[q] = make_float4(0.f, 0.f, 0.f, 0.f);
    float4 vcur[8], vnxt[8];
#pragma unroll
    for (int u = 0; u < 8; ++u) vcur[u] = ldnt4((const float4*)(vb + (size_t)(wave * 64 + u) * 1024) + lane);
#pragma unroll 1
    for (int k0 = 0; k0 < 64; k0 += 8) {
      if (k0 + 8 < 64) {
#pragma unroll
        for (int u = 0; u < 8; ++u) vnxt[u] = ldnt4((const float4*)(vb + (size_t)(wave * 64 + k0 + 8 + u) * 1024) + lane);
      }
#pragma unroll
      for (int u = 0; u < 8; ++u) {
        const float4 v = vcur[u];
        float4 pa = *(const float4*)(pl + (wave * 64 + k0 + u) * 8);
        float4 pb = *(const float4*)(pl + (wave * 64 + k0 + u) * 8 + 4);
        float pp[8] = {pa.x, pa.y, pa.z, pa.w, pb.x, pb.y, pb.z, pb.w};
#pragma unroll
        for (int q = 0; q < 8; ++q) {
          acc[q].x += pp[q] * v.x; acc[q].y += pp[q] * v.y; acc[q].z += pp[q] * v.z; acc[q].w += pp[q] * v.w;
        }
      }
#pragma unroll
      for (int u = 0; u < 8; ++u) vcur[u] = vnxt[u];
    }
#pragma unroll
    for (int q = 0; q < 8; ++q) *(float4*)(op + (wave * 8 + q) * 256 + lane * 4) = acc[q];
  }
  __syncthreads();
  {
    const int d = tid;
#pragma unroll
    for (int q = 0; q < 8; ++q) {
      float M = fmaxf(fmaxf(ml[(0 * 8 + q) * 2], ml[(1 * 8 + q) * 2]), fmaxf(ml[(2 * 8 + q) * 2], ml[(3 * 8 + q) * 2]));
      float den = 0.f, num = 0.f;
#pragma unroll
      for (int w = 0; w < 4; ++w) {
        float f = __expf((ml[(w * 8 + q) * 2] - M) * 0.0625f);
        den += f * ml[(w * 8 + q) * 2 + 1];
        num += f * op[(w * 8 + q) * 256 + d];
      }
      att[(t0 + q) * 1024 + hd * 256 + d] = f2bf(num / den);
    }
  }
  __syncthreads();
}

__device__ void phase_attn(const Params& p, int l, unsigned char* smem) {
  const int G = gridDim.x, b0 = blockIdx.x;
  if (b0 & 1) {
    for (int it = b0; it < 512 + 1024; it += G) if (it >= 512) attn_prompt_block(p, l, it - 512, smem);
    for (int it = b0; it < 512; it += G) attn_sample_block(p, l, it, smem);
  } else {
    for (int it = b0; it < 512 + 1024; it += G) {
      if (it < 512) attn_sample_block(p, l, it, smem);
      else attn_prompt_block(p, l, it - 512, smem);
    }
  }
}

__device__ __forceinline__ void ins16(float (&L)[16], float x) {
#pragma unroll
  for (int j = 0; j < 16; ++j) { float hi = __builtin_fmaxf(L[j], x); x = __builtin_fminf(L[j], x); L[j] = hi; }
}
__device__ void phase_route(const Params& p, int l, unsigned char* smem) {
  const int tid = TIDX, lane = tid & 63, wave = tid >> 6;
  const int g = lane >> 4, li = lane & 15;
  float* s = (float*)smem;
  float* lv = (float*)(smem + 66560);
  const u16* pq = (const u16*)(p.ws + W_PQ);
  const u16* keyb = (const u16*)(p.ws + W_KEYB);
  int* eidx = (int*)(p.ws + W_EIDX);
  float* gate = (float*)(p.ws + W_GATE);
  for (int it = blockIdx.x; it < 272 * 8; it += gridDim.x) {
    const int hd = it & 7, tt = it >> 3;
    const int t0 = tt * 64;
#pragma unroll 1
    for (int ph = 0; ph < 2; ++ph) {
      bf16x8 qf[2];
#pragma unroll
      for (int ks = 0; ks < 2; ++ks)
        qf[ks] = *(const bf16x8*)(pq + (size_t)(t0 + wave * 16 + li) * 1024 + hd * 128 + ph * 64 + ks * 32 + g * 8);
      const u16* kb = keyb + ((size_t)((l * 8 + hd) * 2 + ph) * 128) * 64;
#pragma unroll
      for (int nt = 0; nt < 8; ++nt) {
        f32x4 acc = (f32x4){0.f, 0.f, 0.f, 0.f};
#pragma unroll
        for (int ks = 0; ks < 2; ++ks) {
          bf16x8 kf = *(const bf16x8*)(kb + (size_t)(nt * 16 + li) * 64 + ks * 32 + g * 8);
          acc = __builtin_amdgcn_mfma_f32_16x16x32_bf16(kf, qf[ks], acc, 0, 0, 0);
        }
        float* dst = s + (size_t)(ph * 64 + wave * 16 + li) * 130 + (nt >> 2) * 65 + (nt & 3) * 16 + 4 * g;
        dst[0] = acc[0]; dst[1] = acc[1]; dst[2] = acc[2]; dst[3] = acc[3];
      }
    }
    __syncthreads();
    {
      const int row = tid >> 1, hr = tid & 1;
      const float* rp = s + (size_t)row * 130 + hr * 65;
      float L[16];
#pragma unroll
      for (int j = 0; j < 16; ++j) L[j] = -3.0e38f;
#pragma unroll 4
      for (int k = 0; k < 64; ++k) {
        float v = rp[k];
        float x = __uint_as_float((__float_as_uint(v) & ~0x7fu) | (unsigned)(hr * 64 + k));
        ins16(L, x);
      }
      float P[16];
#pragma unroll
      for (int j = 0; j < 16; ++j) P[j] = dpp_f<0xB1>(L[j]);
#pragma unroll
      for (int j = 0; j < 16; ++j) ins16(L, P[j]);
      if (hr == 0) {
#pragma unroll
        for (int j = 0; j < 4; ++j) *(float4*)(lv + row * 16 + 4 * j) = make_float4(L[4 * j], L[4 * j + 1], L[4 * j + 2], L[4 * j + 3]);
      }
    }
    __syncthreads();
    if (tid < 64) {
      const float* v1 = lv + tid * 16;
      const float* v2 = lv + (64 + tid) * 16;
      float a1[16], a2[16];
#pragma unroll
      for (int j = 0; j < 16; ++j) {
        a1[j] = __uint_as_float(__float_as_uint(v1[j]) & ~0x7fu);
        a2[j] = __uint_as_float(__float_as_uint(v2[j]) & ~0x7fu);
      }
      float C[16];
#pragma unroll
      for (int j = 0; j < 16; ++j) C[j] = -3.0e38f;
#pragma unroll
      for (int i = 0; i < 16; ++i) {
#pragma unroll
        for (int j = 0; j < 16 / (i + 1); ++j) {
          float c = a1[i] + a2[j];
          ins16(C, __uint_as_float((__float_as_uint(c) & ~0xffu) | (unsigned)(i * 16 + j)));
        }
      }
      const float m = __uint_as_float(__float_as_uint(C[0]) & ~0xffu);
      float ex[16]; int ee[16]; float sum = 0.f;
#pragma unroll
      for (int k = 0; k < 16; ++k) {
        const unsigned bits = __float_as_uint(C[k]);
        const int id = bits & 0xff;
        ex[k] = __expf(__uint_as_float(bits & ~0xffu) - m);
        sum += ex[k];
        const int i1 = __float_as_uint(v1[id >> 4]) & 0x7f, i2 = __float_as_uint(v2[id & 15]) & 0x7f;
        ee[k] = i1 * 128 + i2;
      }
      const float inv = 1.f / sum;
      const size_t ob = (size_t)(t0 + tid) * 128 + hd * 16;
#pragma unroll
      for (int k = 0; k < 4; ++k) {
        *(int4*)(eidx + ob + 4 * k) = make_int4(ee[4 * k], ee[4 * k + 1], ee[4 * k + 2], ee[4 * k + 3]);
        *(float4*)(gate + ob + 4 * k) = make_float4(ex[4 * k] * inv, ex[4 * k + 1] * inv, ex[4 * k + 2] * inv, ex[4 * k + 3] * inv);
      }
    }
    __syncthreads();
  }
}

typedef __attribute__((ext_vector_type(2))) float f32x2;
__device__ __forceinline__ float peer_dot16(const uint4 ua, const float (&x)[16]) {
  const uint32_t w[4] = {ua.x, ua.y, ua.z, ua.w};
  float d0 = 0.f, d1 = 0.f;
#pragma unroll
  for (int j = 0; j < 4; ++j) {
    f32x2 lo = __builtin_amdgcn_cvt_pk_f32_fp8((int)w[j], false);
    f32x2 hi = __builtin_amdgcn_cvt_pk_f32_fp8((int)w[j], true);
    d0 += lo[0] * x[4 * j] + hi[0] * x[4 * j + 2];
    d1 += lo[1] * x[4 * j + 1] + hi[1] * x[4 * j + 3];
  }
  return d0 + d1;
}
__device__ __forceinline__ void peer_axpy16(float (&acc)[16], const uint4 va, const float ck) {
  const uint32_t w[4] = {va.x, va.y, va.z, va.w};
#pragma unroll
  for (int j = 0; j < 4; ++j) {
    f32x2 lo = __builtin_amdgcn_cvt_pk_f32_fp8((int)w[j], false);
    f32x2 hi = __builtin_amdgcn_cvt_pk_f32_fp8((int)w[j], true);
    acc[4 * j] += ck * lo[0]; acc[4 * j + 1] += ck * lo[1]; acc[4 * j + 2] += ck * hi[0]; acc[4 * j + 3] += ck * hi[1];
  }
}
__device__ __forceinline__ void pe_load(uint4 (&U)[8], const unsigned char* tab, int e_lo, int e_hi, int it, int lane) {
  const int ev = (it < 8) ? e_lo : e_hi;
#pragma unroll
  for (int k = 0; k < 8; ++k) {
    const int e = __builtin_amdgcn_readlane(ev, (it & 7) * 8 + k);
    U[k] = ((const uint4*)(tab + (size_t)e * 1024))[lane];
  }
}
__device__ __forceinline__ void pe_half(uint4 (&UC)[8], uint4 (&VC)[8], float (&acc)[16], const float (&x)[16], const unsigned char* ub,
                                        const unsigned char* vb, const float* gate, int e_lo, int e_hi, int t, int it, int lane, int klocal) {
  pe_load(VC, vb, e_lo, e_hi, it, lane);
  const float gt = gate[(size_t)t * 128 + it * 8 + klocal];
  float pp[8];
#pragma unroll
  for (int k = 0; k < 8; ++k) pp[k] = peer_dot16(UC[k], x);
  if (it + 1 < 16) pe_load(UC, ub, e_lo, e_hi, it + 1, lane);
  float r4[4], r2[2], r1;
  {
    const bool up = lane & 32;
#pragma unroll
    for (int i = 0; i < 4; ++i) { float keep = up ? pp[i + 4] : pp[i]; float send = up ? pp[i] : pp[i + 4]; r4[i] = keep + __shfl_xor(send, 32, 64); }
  }
  {
    const bool up = lane & 16;
#pragma unroll
    for (int i = 0; i < 2; ++i) { float keep = up ? r4[i + 2] : r4[i]; float send = up ? r4[i] : r4[i + 2]; r2[i] = keep + __shfl_xor(send, 16, 64); }
  }
  {
    const bool up = lane & 8;
    float keep = up ? r2[1] : r2[0]; float send = up ? r2[0] : r2[1];
    r1 = keep + __shfl_xor(send, 8, 64);
  }
  r1 += dpp_f<0x4E>(r1);
  r1 += dpp_f<0xB1>(r1);
  r1 += __shfl_xor(r1, 4, 64);
  const float coef = gt * gelu_t(r1 * (1.f / 128.f)) * (1.f / 64.f);
#pragma unroll
  for (int k = 0; k < 8; ++k) {
    const int sl = ((k >> 2) & 1) * 32 + ((k >> 1) & 1) * 16 + (k & 1) * 8;
    const float ck = __int_as_float(__builtin_amdgcn_readlane(__float_as_int(coef), sl));
    peer_axpy16(acc, VC[k], ck);
  }
}
__device__ void phase_peer(const Params& p, int l) {
  const int lane = TIDX & 63, gw = blockIdx.x * 4 + (TIDX >> 6), nw = gridDim.x * 4;
  const u16* nbuf = (const u16*)(p.ws + W_NB);
  u16* nbw = (u16*)(p.ws + W_NB);
  float* h = (float*)(p.ws + W_H);
  const int* eidx = (const int*)(p.ws + W_EIDX);
  const float* gate = (const float*)(p.ws + W_GATE);
  const unsigned char* ub = p.ws + W_UB + (size_t)l * 16384 * 1024;
  const unsigned char* vb = p.ws + W_VB + (size_t)l * 16384 * 1024;
  const int klocal = ((lane >> 5) & 1) * 4 + ((lane >> 4) & 1) * 2 + ((lane >> 3) & 1);
  for (int tw = gw; tw < NTOK; tw += nw) {
    const int t = __builtin_amdgcn_readfirstlane(tw);
    const int e_lo = eidx[(size_t)t * 128 + lane], e_hi = eidx[(size_t)t * 128 + 64 + lane];
    float x[16];
    {
      const float* hr0 = h + (size_t)t * 1024 + 16 * lane;
      const float* gf = p.norm_ffn_g + l * 1024 + 16 * lane;
      float ss0 = 0.f;
#pragma unroll
      for (int j = 0; j < 4; ++j) {
        float4 a = *(const float4*)(hr0 + 4 * j);
        x[4 * j] = a.x; x[4 * j + 1] = a.y; x[4 * j + 2] = a.z; x[4 * j + 3] = a.w;
        ss0 += a.x * a.x + a.y * a.y + a.z * a.z + a.w * a.w;
      }
      ss0 = wave_sum(ss0);
      const float r0 = rsqrtf(ss0 * (1.f / 1024.f) + 1e-6f);
#pragma unroll
      for (int j = 0; j < 4; ++j) {
        float4 gq = *(const float4*)(gf + 4 * j);
        x[4 * j] *= r0 * gq.x; x[4 * j + 1] *= r0 * gq.y; x[4 * j + 2] *= r0 * gq.z; x[4 * j + 3] *= r0 * gq.w;
      }
    }
    float acc[16];
#pragma unroll
    for (int i = 0; i < 16; ++i) acc[i] = 0.f;
    uint4 ua[8], va[8];
    pe_load(ua, ub, e_lo, e_hi, 0, lane);
#pragma unroll 1
    for (int it = 0; it < 16; ++it) pe_half(ua, va, acc, x, ub, vb, gate, e_lo, e_hi, t, it, lane, klocal);
    float* hr = h + (size_t)t * 1024 + 16 * lane;
    float hv[16];
#pragma unroll
    for (int j = 0; j < 4; ++j) {
      float4 a = *(const float4*)(hr + 4 * j);
      hv[4 * j] = a.x + acc[4 * j]; hv[4 * j + 1] = a.y + acc[4 * j + 1]; hv[4 * j + 2] = a.z + acc[4 * j + 2]; hv[4 * j + 3] = a.w + acc[4 * j + 3];
    }
    float ss = 0.f;
#pragma unroll
    for (int i = 0; i < 16; ++i) ss += hv[i] * hv[i];
    ss = wave_sum(ss);
    const float r = rsqrtf(ss * (1.f / 1024.f) + 1e-6f);
    const float* gsrc = ((l == 1) ? p.final_norm_g : p.norm_mix_g + 1024) + 16 * lane;
    float yv[16];
#pragma unroll
    for (int j = 0; j < 4; ++j) {
      float4 gq = *(const float4*)(gsrc + 4 * j);
      yv[4 * j] = hv[4 * j] * r * gq.x; yv[4 * j + 1] = hv[4 * j + 1] * r * gq.y; yv[4 * j + 2] = hv[4 * j + 2] * r * gq.z; yv[4 * j + 3] = hv[4 * j + 3] * r * gq.w;
    }
    if (l == 1) {
      float* yo = ((t < NPR) ? p.out + O_YP + (size_t)t * 1024 : p.out + O_YS + (size_t)(t - NPR) * 1024) + 16 * lane;
#pragma unroll
      for (int j = 0; j < 4; ++j) *(float4*)(yo + 4 * j) = make_float4(yv[4 * j], yv[4 * j + 1], yv[4 * j + 2], yv[4 * j + 3]);
    } else {
#pragma unroll
      for (int j = 0; j < 4; ++j) *(float4*)(hr + 4 * j) = make_float4(hv[4 * j], hv[4 * j + 1], hv[4 * j + 2], hv[4 * j + 3]);
      u16* nd = nbw + (size_t)t * 1024 + 16 * lane;
      *(uint4*)nd = make_uint4(pack2(yv[0], yv[1]), pack2(yv[2], yv[3]), pack2(yv[4], yv[5]), pack2(yv[6], yv[7]));
      *(uint4*)(nd + 8) = make_uint4(pack2(yv[8], yv[9]), pack2(yv[10], yv[11]), pack2(yv[12], yv[13]), pack2(yv[14], yv[15]));
    }
  }
}

__global__ void __launch_bounds__(256, 2) mega(Params p) {
  __shared__ __attribute__((aligned(16))) unsigned char smem[SMEM_BYTES];
  cg::grid_group grid = cg::this_grid();
  __shared__ uint4 xb_words;
  if (threadIdx.x == 0) xb_words = make_uint4(0u, 0u, 0u, 0u);
  __syncthreads();
  XcdBarrier xb = xcd_barrier_post((unsigned*)(p.ws + W_BAR), (volatile LAS unsigned*)&xb_words);
  phase0a(p, smem);
  if (p.out == nullptr) grid.sync();
  xcd_barrier(xb);
  float* h = (float*)(p.ws + W_H);
  const u16* nbuf = (const u16*)(p.ws + W_NB);
  for (int l = 0; l < 2; ++l) {
    const u16* WT = (const u16*)(p.ws + W_WT) + (size_t)l * WTROWS * 1024;
    phase_g1(p, l, smem);
    xcd_barrier(xb);
    if (PROBE_DUP == 1) { phase_g1(p, l, smem); xcd_barrier(xb); }
    phase_prep(p, l, smem);
    xcd_barrier(xb);
    if (PROBE_DUP == 2) { phase_prep(p, l, smem); xcd_barrier(xb); }
    phase_mix(p, l, smem);
    xcd_barrier(xb);
    if (PROBE_DUP == 3) { phase_mix(p, l, smem); xcd_barrier(xb); }
    phase_onorm(p, l);
    xcd_barrier(xb);
    if (PROBE_DUP == 7) { phase_onorm(p, l); xcd_barrier(xb); }
    {
      EpiRes e{l == 0 ? p.x_prompt : h, l == 0 ? p.x_sample : h + (size_t)NPR * 1024, h, (u16*)(p.ws + W_NB), (float*)(p.ws + W_PART), p.norm_mem_g + l * 1024};
      phase_gemm1024((const u16*)(p.ws + W_CAT), WT + (size_t)3200 * 1024, smem, e);
    }
    xcd_barrier(xb);
    {
      EpiBF16Rstd e{(u16*)(p.ws + W_QM), 1024, 1024, (const float*)(p.ws + W_PART)};
      phase_gemm1024(nbuf, WT + (size_t)4224 * 1024, smem, e);
    }
    xcd_barrier(xb);
    phase_attn(p, l, smem);
    xcd_barrier(xb);
    if (PROBE_DUP == 4) { phase_attn(p, l, smem); xcd_barrier(xb); }
    {
      EpiRes e{h, h + (size_t)NPR * 1024, h, (u16*)(p.ws + W_NB), (float*)(p.ws + W_PART), p.norm_ffn_g + l * 1024};
      phase_gemm1024((const u16*)(p.ws + W_ATT), WT + (size_t)5248 * 1024, smem, e);
    }
    xcd_barrier(xb);
    {
      EpiBF16Rstd e{(u16*)(p.ws + W_PQ), 1024, 1024, (const float*)(p.ws + W_PART)};
      phase_gemm1024(nbuf, WT + (size_t)6272 * 1024, smem, e);
    }
    xcd_barrier(xb);
    phase_route(p, l, smem);
    xcd_barrier(xb);
    if (PROBE_DUP == 5) { phase_route(p, l, smem); xcd_barrier(xb); }
    phase_peer(p, l);
    xcd_barrier(xb);
    if (PROBE_DUP == 6 && l == 1) { phase_peer(p, l); xcd_barrier(xb); }
  }
}

extern "C" void kernel_launch(void* const* d_in, const int* in_sizes, int n_in, void* d_out, int out_size, void* d_ws,
                              size_t ws_size, hipStream_t stream) {
  static int grid_blocks = 0;
  if (!grid_blocks) {
    int dev = 0, cus = 0, per_cu = 0;
    hipGetDevice(&dev);
    hipDeviceGetAttribute(&cus, hipDeviceAttributeMultiprocessorCount, dev);
    hipOccupancyMaxActiveBlocksPerMultiprocessor(&per_cu, mega, 256, 0);
    if (per_cu > 2) per_cu = 2;
    if (per_cu < 1) per_cu = 1;
    grid_blocks = cus * per_cu;
  }
  Params p{};
  const float** pp = (const float**)&p;
  for (int i = 0; i < 30; ++i) pp[i] = (const float*)d_in[i];
  p.out = (float*)d_out;
  p.ws = (unsigned char*)d_ws;
  hipMemsetAsync((unsigned char*)d_ws + W_BAR, 0, XCD_BAR_WORDS * 4, stream);
  void* args[] = {&p};
  hipError_t e = hipLaunchCooperativeKernel((void*)mega, dim3(grid_blocks), dim3(256), args, 0, stream);
  if (e != hipSuccess) fprintf(stderr, "cooperative launch failed: %s (grid %d)\n", hipGetErrorString(e), grid_blocks);
}
```
